# Optimizing an MI355X kernel written in HIP

```python
import math
import jax
import jax.numpy as jnp
from jax import lax
import numpy as np

D_MODEL = 1024
BATCH = 8
SEQ = 8192
DEPTH = 2

S5_GROUPS = 16
S5_GROUP_DIM = 16
S5_WIDTH = S5_GROUPS * S5_GROUP_DIM
S5_STATE = 64
S5_DT_MIN = 1e-3
S5_DT_MAX = 1e-1

MLSTM_HEADS = 4
MLSTM_HEAD_DIM = 96
MLSTM_WIDTH = MLSTM_HEADS * MLSTM_HEAD_DIM
MLSTM_CHUNK = 128
CONV_WIDTH = 4

FOX_HEADS = 6
FOX_HEAD_DIM = 64
FOX_WIDTH = FOX_HEADS * FOX_HEAD_DIM
FOX_BLOCK = 128

N_BRANCHES = 3
FFN_HIDDEN = -(-8 * D_MODEL // (3 * 256)) * 256
EPS = 1e-6

IN_SIZES = (S5_WIDTH,
            MLSTM_WIDTH,
            MLSTM_WIDTH,
            MLSTM_WIDTH,
            MLSTM_HEADS,
            MLSTM_HEADS,
            FOX_WIDTH,
            FOX_WIDTH,
            FOX_WIDTH,
            FOX_HEADS,
            N_BRANCHES * D_MODEL)
N_IN = S5_WIDTH + 3 * MLSTM_WIDTH + 2 * MLSTM_HEADS + 3 * FOX_WIDTH + FOX_HEADS + N_BRANCHES * D_MODEL

kernel_name = 'hybrid_s5_mlstm_fox_adaln'


def _in_offset(idx):
    return sum(IN_SIZES[:idx])


def _split_in(z):
    parts = []
    start = 0
    for n in IN_SIZES:
        parts.append(z[..., start:start + n])
        start += n
    return parts


def _rmsnorm(x, g):
    xf = x.astype(jnp.float32)
    y = xf * lax.rsqrt(jnp.mean(xf * xf, axis=-1, keepdims=True) + EPS)
    return (y * g.astype(jnp.float32)).astype(x.dtype)


def _complex_combine(e1, e2):
    a1r, a1i, b1r, b1i = e1
    a2r, a2i, b2r, b2i = e2
    ar = a2r * a1r - a2i * a1i
    ai = a2r * a1i + a2i * a1r
    br = a2r * b1r - a2i * b1i + b2r
    bi = a2r * b1i + a2i * b1r + b2i
    return (ar, ai, br, bi)


def _s5(u, a_re, a_im, log_dt, b_re, b_im, c_re, c_im, d, w_glu):
    bsz, seq, _ = u.shape
    f32 = jnp.float32
    uf = u.astype(f32).reshape(bsz, seq, S5_GROUPS, S5_GROUP_DIM)
    are, aim = a_re.astype(f32), a_im.astype(f32)
    dt = jnp.exp(log_dt.astype(f32))[:, None]
    mag = jnp.exp(dt * are)
    ang = dt * aim
    abar_r, abar_i = mag * jnp.cos(ang), mag * jnp.sin(ang)
    den = are * are + aim * aim
    p, q = abar_r - 1.0, abar_i
    coef_r = (p * are + q * aim) / den
    coef_i = (q * are - p * aim) / den
    br, bi = b_re.astype(f32), b_im.astype(f32)
    bbar_r = coef_r[..., None] * br - coef_i[..., None] * bi
    bbar_i = coef_r[..., None] * bi + coef_i[..., None] * br
    bu_r = jnp.einsum('blgp,gnp->blgn', uf, bbar_r)
    bu_i = jnp.einsum('blgp,gnp->blgn', uf, bbar_i)
    a_r = jnp.broadcast_to(abar_r, (1, seq) + abar_r.shape)
    a_i = jnp.broadcast_to(abar_i, (1, seq) + abar_i.shape)
    _, _, s_r, s_i = lax.associative_scan(_complex_combine, (a_r, a_i, bu_r, bu_i), axis=1)
    y = (jnp.einsum('blgn,gpn->blgp', s_r, c_re.astype(f32))
         - jnp.einsum('blgn,gpn->blgp', s_i, c_im.astype(f32)))
    y = y.reshape(bsz, seq, S5_WIDTH) + d.astype(f32) * uf.reshape(bsz, seq, S5_WIDTH)
    y = jax.nn.gelu(y)
    y = y * jax.nn.sigmoid(y @ w_glu.astype(f32))
    return y.astype(u.dtype)


def _causal_conv(x, w, b):
    seq = x.shape[1]
    xp = jnp.pad(x, ((0, 0), (CONV_WIDTH - 1, 0), (0, 0)))
    y = b
    for tap in range(CONV_WIDTH):
        y = y + w[tap] * xp[:, tap:tap + seq]
    return y


def _mlstm(qk_in, v_in, o_in, i_pre, f_pre, conv_w, conv_b, wq, wk, norm_g):
    bsz, seq, _ = qk_in.shape
    f32 = jnp.float32
    H, dh, C = MLSTM_HEADS, MLSTM_HEAD_DIM, MLSTM_CHUNK
    nc = seq // C
    cx = jax.nn.silu(_causal_conv(qk_in.astype(f32), conv_w.astype(f32), conv_b.astype(f32)))
    cx = cx.reshape(bsz, seq, H, dh)
    q = jnp.einsum('blhd,hde->bhle', cx, wq.astype(f32))
    k = jnp.einsum('blhd,hde->bhle', cx, wk.astype(f32)) * (dh ** -0.5)
    v = v_in.astype(f32).reshape(bsz, seq, H, dh).transpose(0, 2, 1, 3)
    li = i_pre.astype(f32).transpose(0, 2, 1)
    lf = jax.nn.log_sigmoid(f_pre.astype(f32)).transpose(0, 2, 1)

    def to_chunks(t):
        return jnp.moveaxis(t.reshape((bsz, H, nc, C) + t.shape[3:]), 2, 0)

    causal = jnp.tril(jnp.ones((C, C), dtype=bool))

    def step(carry, xs):
        c_st, n_st, m_st = carry
        qc, kc, vc, lic, lfc = xs
        b = jnp.cumsum(lfc, axis=-1)
        dmat = b[..., :, None] - b[..., None, :] + lic[..., None, :]
        dmat = jnp.where(causal, dmat, -jnp.inf)
        m_inter = b + m_st[..., None]
        m_t = jnp.maximum(m_inter, jnp.max(dmat, axis=-1))
        s = jnp.einsum('bhtd,bhsd->bhts', qc, kc) * jnp.exp(dmat - m_t[..., None])
        inter = jnp.exp(m_inter - m_t)
        num = (jnp.einsum('bhts,bhsd->bhtd', s, vc)
               + inter[..., None] * jnp.einsum('bhvk,bhtk->bhtv', c_st, qc))
        den = jnp.sum(s, axis=-1) + inter * jnp.einsum('bhk,bhtk->bht', n_st, qc)
        h = num / jnp.maximum(jnp.abs(den), jnp.exp(-m_t))[..., None]
        b_last = b[..., -1]
        w = b_last[..., None] - b + lic
        m_new = jnp.maximum(b_last + m_st, jnp.max(w, axis=-1))
        decay = jnp.exp(b_last + m_st - m_new)
        ws = jnp.exp(w - m_new[..., None])
        c_new = decay[..., None, None] * c_st + jnp.einsum('bhsv,bhsk->bhvk', vc * ws[..., None], kc)
        n_new = decay[..., None] * n_st + jnp.einsum('bhs,bhsk->bhk', ws, kc)
        return (c_new, n_new, m_new), h

    init = (jnp.zeros((bsz, H, dh, dh), f32), jnp.zeros((bsz, H, dh), f32), jnp.zeros((bsz, H), f32))
    _, hs = lax.scan(step, init, (to_chunks(q), to_chunks(k), to_chunks(v), to_chunks(li), to_chunks(lf)))
    h = jnp.moveaxis(hs, 0, 2).reshape(bsz, H, seq, dh).transpose(0, 2, 1, 3)
    h = h * lax.rsqrt(jnp.mean(h * h, axis=-1, keepdims=True) + EPS)
    h = h.reshape(bsz, seq, MLSTM_WIDTH) * norm_g.astype(f32)
    h = jax.nn.sigmoid(o_in.astype(f32)) * h
    return h.astype(qk_in.dtype)


def _fox(q_in, k_in, v_in, f_pre):
    bsz, seq, _ = q_in.shape
    f32 = jnp.float32
    H, dh, BLK = FOX_HEADS, FOX_HEAD_DIM, FOX_BLOCK
    nb = seq // BLK

    def heads(t):
        return t.astype(f32).reshape(bsz, seq, H, dh).transpose(0, 2, 1, 3)

    q = heads(q_in) * (dh ** -0.5)
    k, v = heads(k_in), heads(v_in)
    logf = jax.nn.log_sigmoid(f_pre.astype(f32)).transpose(0, 2, 1)
    F = jnp.cumsum(logf, axis=-1)
    pos = jnp.arange(seq, dtype=jnp.int32)
    q_blocks = jnp.moveaxis(q.reshape(bsz, H, nb, BLK, dh), 2, 0)
    f_blocks = jnp.moveaxis(F.reshape(bsz, H, nb, BLK), 2, 0)
    pos_blocks = pos.reshape(nb, BLK)

    def block(args):
        qb, fb, pb = args
        s = jnp.einsum('bhtd,bhsd->bhts', qb, k) + (fb[..., None] - F[:, :, None, :])
        s = jnp.where(pb[:, None] >= pos[None, :], s, -jnp.inf)
        p = jax.nn.softmax(s, axis=-1)
        return jnp.einsum('bhts,bhsd->bhtd', p, v)

    out = lax.map(block, (q_blocks, f_blocks, pos_blocks))
    out = jnp.moveaxis(out, 0, 2).reshape(bsz, H, seq, dh).transpose(0, 2, 1, 3)
    return out.reshape(bsz, seq, FOX_WIDTH).astype(q_in.dtype)


def _mixer(h, w_in, b_in, s5_a_re, s5_a_im, s5_log_dt, s5_b_re, s5_b_im, s5_c_re, s5_c_im,
           s5_d, s5_w_glu, mlstm_conv_w, mlstm_conv_b, mlstm_wq, mlstm_wk, mlstm_norm_g,
           w_up_s5, w_up_mlstm, w_up_fox, w_out):
    z = h @ w_in + b_in
    (s5_u, m_qk, m_v, m_o, m_i, m_f, f_q, f_k, f_v, f_f, gates) = _split_in(z)
    y_s5 = _s5(s5_u, s5_a_re, s5_a_im, s5_log_dt, s5_b_re, s5_b_im, s5_c_re, s5_c_im,
               s5_d, s5_w_glu) @ w_up_s5
    y_m = _mlstm(m_qk, m_v, m_o, m_i, m_f, mlstm_conv_w, mlstm_conv_b, mlstm_wq, mlstm_wk,
                 mlstm_norm_g) @ w_up_mlstm
    y_f = _fox(f_q, f_k, f_v, f_f) @ w_up_fox
    g_s5, g_m, g_f = jnp.split(jax.nn.sigmoid(gates), N_BRANCHES, axis=-1)
    merged = g_s5 * y_s5 + g_m * y_m + g_f * y_f
    return merged @ w_out


def _swiglu(h, w1, w3, w2):
    return (jax.nn.silu(h @ w1) * (h @ w3)) @ w2


def setup_inputs(seed: int = 0) -> dict:
    key = jax.random.key(seed)
    ks = iter(jax.random.split(key, 32))

    def nrm(shape, scale):
        return scale * jax.random.normal(next(ks), shape, jnp.float32)

    G, N, P = S5_GROUPS, S5_STATE, S5_GROUP_DIM
    H, dh = MLSTM_HEADS, MLSTM_HEAD_DIM
    x = nrm((BATCH, SEQ, D_MODEL), 1.0)
    c = nrm((BATCH, D_MODEL), 1.0)
    mod_w = nrm((DEPTH, D_MODEL, 6 * D_MODEL), 0.5 * D_MODEL ** -0.5)
    mod_b = nrm((DEPTH, 6 * D_MODEL), 0.02)
    norm1_g = 1.0 + nrm((DEPTH, D_MODEL), 0.02)
    norm2_g = 1.0 + nrm((DEPTH, D_MODEL), 0.02)
    w_in = nrm((DEPTH, D_MODEL, N_IN), D_MODEL ** -0.5)
    b_in = nrm((DEPTH, N_IN), 0.02)
    off_mf = _in_offset(5)
    off_ff = _in_offset(9)
    b_in = b_in.at[:, off_mf:off_mf + MLSTM_HEADS].add(jnp.linspace(3.0, 6.0, MLSTM_HEADS, dtype=jnp.float32))
    b_in = b_in.at[:, off_ff:off_ff + FOX_HEADS].add(jnp.linspace(2.0, 5.0, FOX_HEADS, dtype=jnp.float32))
    s5_a_re = -0.5 + nrm((DEPTH, G, N), 0.01)
    s5_a_im = math.pi * jnp.arange(N, dtype=jnp.float32) + nrm((DEPTH, G, N), 0.01)
    s5_log_dt = jax.random.uniform(next(ks), (DEPTH, G), jnp.float32,
                                   math.log(S5_DT_MIN), math.log(S5_DT_MAX))
    s5_b_re = nrm((DEPTH, G, N, P), (2.0 * P) ** -0.5)
    s5_b_im = nrm((DEPTH, G, N, P), (2.0 * P) ** -0.5)
    s5_c_re = nrm((DEPTH, G, P, N), (2.0 * N) ** -0.5)
    s5_c_im = nrm((DEPTH, G, P, N), (2.0 * N) ** -0.5)
    s5_d = nrm((DEPTH, S5_WIDTH), 1.0)
    s5_w_glu = nrm((DEPTH, S5_WIDTH, S5_WIDTH), S5_WIDTH ** -0.5)
    mlstm_conv_w = nrm((DEPTH, CONV_WIDTH, MLSTM_WIDTH), CONV_WIDTH ** -0.5)
    mlstm_conv_b = nrm((DEPTH, MLSTM_WIDTH), 0.02)
    mlstm_wq = nrm((DEPTH, H, dh, dh), dh ** -0.5)
    mlstm_wk = nrm((DEPTH, H, dh, dh), dh ** -0.5)
    mlstm_norm_g = 1.0 + nrm((DEPTH, MLSTM_WIDTH), 0.02)
    w_up_s5 = nrm((DEPTH, S5_WIDTH, D_MODEL), S5_WIDTH ** -0.5)
    w_up_mlstm = nrm((DEPTH, MLSTM_WIDTH, D_MODEL), MLSTM_WIDTH ** -0.5)
    w_up_fox = nrm((DEPTH, FOX_WIDTH, D_MODEL), FOX_WIDTH ** -0.5)
    w_out = nrm((DEPTH, D_MODEL, D_MODEL), D_MODEL ** -0.5)
    ffn_w1 = nrm((DEPTH, D_MODEL, FFN_HIDDEN), D_MODEL ** -0.5)
    ffn_w3 = nrm((DEPTH, D_MODEL, FFN_HIDDEN), D_MODEL ** -0.5)
    ffn_w2 = nrm((DEPTH, FFN_HIDDEN, D_MODEL), FFN_HIDDEN ** -0.5)
    final_g = 1.0 + nrm((D_MODEL,), 0.02)
    return {'x': x, 'c': c, 'mod_w': mod_w, 'mod_b': mod_b, 'norm1_g': norm1_g, 'norm2_g': norm2_g,
            'w_in': w_in, 'b_in': b_in, 's5_a_re': s5_a_re, 's5_a_im': s5_a_im, 's5_log_dt': s5_log_dt,
            's5_b_re': s5_b_re, 's5_b_im': s5_b_im, 's5_c_re': s5_c_re, 's5_c_im': s5_c_im,
            's5_d': s5_d, 's5_w_glu': s5_w_glu, 'mlstm_conv_w': mlstm_conv_w, 'mlstm_conv_b': mlstm_conv_b,
            'mlstm_wq': mlstm_wq, 'mlstm_wk': mlstm_wk, 'mlstm_norm_g': mlstm_norm_g,
            'w_up_s5': w_up_s5, 'w_up_mlstm': w_up_mlstm, 'w_up_fox': w_up_fox, 'w_out': w_out,
            'ffn_w1': ffn_w1, 'ffn_w3': ffn_w3, 'ffn_w2': ffn_w2, 'final_g': final_g}


def reference(x, c, mod_w, mod_b, norm1_g, norm2_g, w_in, b_in, s5_a_re, s5_a_im, s5_log_dt,
              s5_b_re, s5_b_im, s5_c_re, s5_c_im, s5_d, s5_w_glu, mlstm_conv_w, mlstm_conv_b,
              mlstm_wq, mlstm_wk, mlstm_norm_g, w_up_s5, w_up_mlstm, w_up_fox, w_out,
              ffn_w1, ffn_w3, ffn_w2, final_g):
    cf = jax.nn.silu(c)
    for l in range(DEPTH):
        mod = cf @ mod_w[l] + mod_b[l]
        sh1, sc1, g1, sh2, sc2, g2 = [m[:, None, :] for m in jnp.split(mod, 6, axis=-1)]
        h = _rmsnorm(x, norm1_g[l]) * (1.0 + sc1) + sh1
        x = x + g1 * _mixer(h, w_in[l], b_in[l], s5_a_re[l], s5_a_im[l], s5_log_dt[l],
                            s5_b_re[l], s5_b_im[l], s5_c_re[l], s5_c_im[l], s5_d[l], s5_w_glu[l],
                            mlstm_conv_w[l], mlstm_conv_b[l], mlstm_wq[l], mlstm_wk[l],
                            mlstm_norm_g[l], w_up_s5[l], w_up_mlstm[l], w_up_fox[l], w_out[l])
        h = _rmsnorm(x, norm2_g[l]) * (1.0 + sc2) + sh2
        x = x + g2 * _swiglu(h, ffn_w1[l], ffn_w3[l], ffn_w2[l])
    return _rmsnorm(x, final_g)
```

```cpp
#define MK_PER_PHASE 0
#include <hip/hip_runtime.h>
#include <hip/hip_cooperative_groups.h>
#include <cstdio>
#include <cstdint>
namespace pg8 {
#define PG8_LAS __attribute__((address_space(3)))
typedef unsigned short bf16_t;
typedef short bf16x8 __attribute__((ext_vector_type(8)));
typedef float f32x4 __attribute__((ext_vector_type(4)));
typedef unsigned u32x4 __attribute__((ext_vector_type(4)));
constexpr int BM = 256, BK = 64, HALF = 128, HTB = HALF * BK * 2  , STAGE_BYTES = 8 * HTB, NXCD = 8, WGM = 4;

__host__ __device__ __forceinline__ int lds_byte(int r, int c) { const int st = (r >> 4) * 2 + (c >> 5), rr = r & 15, cc = c & 31, ob = rr * 64 + cc * 2; return st * 1024 + (ob ^ (((ob >> 9) & 1) << 5)); }
__host__ __device__ __forceinline__ void stage_rc(int b, int& R, int& C) { const int st = b / 1024, sb = b % 1024, swz = sb ^ (((sb >> 9) & 1) << 5); R = (st >> 1) * 16 + swz / 64; C = (st & 1) * 32 + (swz % 64) / 2; }
__host__ __device__ __forceinline__ int perm32(int rho) { const int n = rho >> 4, i = rho & 15; return 8 * (i >> 2) + 4 * n + (i & 3); }

struct Unit { int pm, pn; };
struct Gemm { const bf16_t* A; const bf16_t* Bt; int M, N, K, lda, ldb; };

struct StaticOrder {
    int nM, nN, nwg, G, c, rev;
    __host__ __device__ void init(int M, int N, int G_, int c_, int rev_ = 0) { nM = M / BM; nN = N / BM; nwg = nM * nN; G = G_; c = c_; rev = rev_; }
    __host__ __device__ bool next(int i, Unit& u) const {
        const long L = (long)i * G + c; if (L >= nwg) return false;
        int wgid = (int)L; { const int q = nwg / NXCD, r = nwg % NXCD, xcd = wgid % NXCD, off = wgid / NXCD; wgid = (xcd < r ? xcd * (q + 1) : r * (q + 1) + (xcd - r) * q) + off; }
        const int nig = WGM * nN, gid = wgid / nig, fm = gid * WGM, gsz = (nM - fm) < WGM ? (nM - fm) : WGM;
        u.pm = fm + ((wgid % nig) % gsz); u.pn = (wgid % nig) / gsz; if (rev) { const int cs = nM / NXCD; u.pm = (u.pm / cs) * cs + (cs - 1 - u.pm % cs); } return true;
    }
    __device__ __forceinline__ void a_ready(const Unit&) const {}
    __device__ __forceinline__ void done(const Unit&) const {}
};

__device__ __forceinline__ unsigned cvt_pk_bf16(float lo, float hi) { unsigned r; asm volatile("v_cvt_pk_bf16_f32 %0, %1, %2" : "=v"(r) : "v"(lo), "v"(hi)); return r; }
typedef float f32x2 __attribute__((ext_vector_type(2)));


template <class Epi, class Sched, bool ALIGN_EPI = false, bool SP2 = false>
__device__ __forceinline__ void gemm_phase(PG8_LAS unsigned char* lds, const Gemm g, const Sched& S, const Epi& E) {
    int tid_o = threadIdx.x; asm volatile("" : "+v"(tid_o));
    const int tid = tid_o, wid = __builtin_amdgcn_readfirstlane(tid >> 6), lane = tid & 63, wr = wid >> 2, wc = wid & 3, fr = lane & 15, fq = lane >> 4;
    const int K = g.K; int nt = K / BK; asm volatile("" : "+s"(nt));
    unsigned voffA[2], voffB[2];
#pragma unroll
    for (int i = 0; i < 2; ++i) { int R, C; stage_rc(tid * 16 + i * 8192, R, C); const int Rb = Epi::PERM ? ((R & ~31) + perm32(R & 31)) : R;
        voffA[i] = (unsigned)(R * g.lda + C) * 2u; voffB[i] = (unsigned)(Rb * g.ldb + C) * 2u; }
    const size_t kstep = (size_t)(BK * 2);
    const size_t hstepA = (size_t)HALF * g.lda * 2, hstepB = (size_t)HALF * g.ldb * 2;
    const size_t tstepA = 2 * hstepA, tstepB = 2 * hstepB;
    const unsigned ldsw = (unsigned)wid * 1024u;
    const int aoff = lds_byte(wr * 64 + fr, fq * 8), boff = lds_byte(wc * 32 + fr, fq * 8);
#define PG8_SA(b, h) (((b) * 2 + (h)) * HTB)
#define PG8_SB(b, h) ((4 + (b) * 2 + (h)) * HTB)
#define PG8_STAGE(bufoff, gbase, voff) do { _Pragma("unroll") for (int _i = 0; _i < 2; ++_i) \
        __builtin_amdgcn_global_load_lds((const unsigned*)((const char*)(gbase) + (voff)[_i]), (PG8_LAS unsigned*)(lds + (bufoff) + ldsw + _i * 8192), 16, 0, 0); } while (0)
#define PG8_LDA(dst, b, h) do { _Pragma("unroll") for (int m = 0; m < 4; ++m) _Pragma("unroll") for (int k = 0; k < 2; ++k) dst[m][k] = *(const PG8_LAS bf16x8*)(lds + PG8_SA(b, h) + aoff + m * 2048 + k * 1024); } while (0)
#define PG8_LDB(dst, b, h) do { _Pragma("unroll") for (int n = 0; n < 2; ++n) _Pragma("unroll") for (int k = 0; k < 2; ++k) dst[n][k] = *(const PG8_LAS bf16x8*)(lds + PG8_SB(b, h) + boff + n * 2048 + k * 1024); } while (0)
#define PG8_MMA(ai, bj, At, Bt) do { __builtin_amdgcn_s_setprio(1); _Pragma("unroll") for (int m = 0; m < 4; ++m) _Pragma("unroll") for (int n = 0; n < 2; ++n) _Pragma("unroll") for (int k = 0; k < 2; ++k) \
        acc[ai][bj][m][n] = __builtin_amdgcn_mfma_f32_16x16x32_bf16(Bt[n][k], At[m][k], acc[ai][bj][m][n], 0, 0, 0); __builtin_amdgcn_s_setprio(0); } while (0)
#define PG8_WAIT_V(n) asm volatile("s_waitcnt vmcnt(" #n ")" ::: "memory")
#define PG8_WAIT_L(n) asm volatile("s_waitcnt lgkmcnt(" #n ")" ::: "memory")
#define PG8_BAR __builtin_amdgcn_s_barrier()
#define PG8_SCHED __builtin_amdgcn_sched_barrier(0)
    Unit cur, nxt; int ui = 0;
    if (!S.next(0, cur)) return;
    f32x4 acc[2][2][4][2];
#pragma unroll
    for (int a = 0; a < 2; ++a)
#pragma unroll
        for (int b = 0; b < 2; ++b)
#pragma unroll
            for (int m = 0; m < 4; ++m)
#pragma unroll
                for (int n = 0; n < 2; ++n) acc[a][b][m][n] = (f32x4){0.f, 0.f, 0.f, 0.f};
    bf16x8 At[4][2], B0[2][2], B1[2][2];
    const char* cA = (const char*)g.A + (size_t)cur.pm * tstepA; const char* cB = (const char*)g.Bt + (size_t)cur.pn * tstepB;
    S.a_ready(cur);
    if constexpr (SP2) {
        PG8_STAGE(PG8_SB(0, 0), cB, voffB); PG8_STAGE(PG8_SB(0, 1), cB + hstepB, voffB); PG8_STAGE(PG8_SA(0, 0), cA, voffA); PG8_STAGE(PG8_SA(0, 1), cA + hstepA, voffA);
        if (wr == 1) PG8_BAR;
        PG8_WAIT_V(2); PG8_BAR;
        PG8_STAGE(PG8_SB(1, 0), cB + kstep, voffB); PG8_STAGE(PG8_SA(1, 0), cA + kstep, voffA); PG8_STAGE(PG8_SB(1, 1), cB + hstepB + kstep, voffB);
        PG8_WAIT_V(6); PG8_BAR;
    } else {
        PG8_STAGE(PG8_SB(0, 0), cB, voffB); PG8_STAGE(PG8_SA(0, 0), cA, voffA); PG8_STAGE(PG8_SB(0, 1), cB + hstepB, voffB); PG8_STAGE(PG8_SA(0, 1), cA + hstepA, voffA);
        if (wr == 1) PG8_BAR;
        PG8_WAIT_V(4); PG8_BAR;
        PG8_STAGE(PG8_SB(1, 0), cB + kstep, voffB); PG8_STAGE(PG8_SA(1, 0), cA + kstep, voffA); PG8_STAGE(PG8_SB(1, 1), cB + hstepB + kstep, voffB);
        PG8_WAIT_V(6); PG8_BAR;
    }
    for (;;) {
        const bool has_next = S.next(ui + 1, nxt);
        const char* nA = has_next ? (const char*)g.A + (size_t)nxt.pm * tstepA : cA; const char* nB = has_next ? (const char*)g.Bt + (size_t)nxt.pn * tstepB : cB;
        for (int t = 0; t < nt; t += 2) {
            const bool last = (t == nt - 2);
            const char* a1 = cA + (size_t)(t + 1) * kstep;
            const char* a2 = last ? nA : cA + (size_t)(t + 2) * kstep; const char* b2 = last ? nB : cB + (size_t)(t + 2) * kstep;
            const char* a3 = a2 + kstep; const char* b3 = b2 + kstep;
            if (last && has_next) S.a_ready(nxt);
            if constexpr (SP2) {
            PG8_LDB(B0, 0, 0); PG8_LDB(B1, 0, 1); PG8_SCHED; PG8_LDA(At, 0, 0); PG8_STAGE(PG8_SA(1, 1), a1 + hstepA, voffA);
            PG8_WAIT_V(8); PG8_WAIT_L(0); PG8_BAR; PG8_MMA(0, 0, At, B0); PG8_MMA(0, 1, At, B1); PG8_BAR; PG8_SCHED;
            PG8_LDA(At, 0, 1); PG8_STAGE(PG8_SB(0, 0), b2, voffB); PG8_STAGE(PG8_SB(0, 1), b2 + hstepB, voffB); PG8_STAGE(PG8_SA(0, 0), a2, voffA);
            PG8_WAIT_V(8); PG8_WAIT_L(0); PG8_BAR; PG8_MMA(1, 0, At, B0); PG8_MMA(1, 1, At, B1); PG8_BAR; PG8_SCHED;
            PG8_LDB(B0, 1, 0); PG8_LDB(B1, 1, 1); PG8_SCHED; PG8_LDA(At, 1, 0); PG8_STAGE(PG8_SA(0, 1), a2 + hstepA, voffA);
            PG8_WAIT_V(8); PG8_WAIT_L(0); PG8_BAR; PG8_MMA(0, 0, At, B0); PG8_MMA(0, 1, At, B1); PG8_BAR; PG8_SCHED;
            PG8_LDA(At, 1, 1); PG8_STAGE(PG8_SB(1, 0), b3, voffB); PG8_STAGE(PG8_SB(1, 1), b3 + hstepB, voffB); PG8_STAGE(PG8_SA(1, 0), a3, voffA);
            PG8_WAIT_V(8); PG8_WAIT_L(0); PG8_BAR; PG8_MMA(1, 0, At, B0); PG8_MMA(1, 1, At, B1); PG8_BAR; PG8_SCHED;
            } else {
            PG8_LDB(B0, 0, 0); PG8_SCHED; PG8_LDA(At, 0, 0); PG8_STAGE(PG8_SA(1, 1), a1 + hstepA, voffA);
            PG8_WAIT_L(8); PG8_BAR; PG8_WAIT_L(0); PG8_MMA(0, 0, At, B0); PG8_BAR; PG8_SCHED;
            PG8_LDB(B1, 0, 1); PG8_STAGE(PG8_SB(0, 0), b2, voffB);
            PG8_BAR; PG8_WAIT_L(0); PG8_MMA(0, 1, At, B1); PG8_BAR;
            PG8_LDA(At, 0, 1); PG8_STAGE(PG8_SA(0, 0), a2, voffA);
            PG8_BAR; PG8_WAIT_L(0); PG8_MMA(1, 0, At, B0); PG8_BAR; PG8_SCHED;
            PG8_STAGE(PG8_SB(0, 1), b2 + hstepB, voffB);
            PG8_WAIT_V(6); PG8_BAR; PG8_MMA(1, 1, At, B1); PG8_BAR;
            PG8_LDB(B0, 1, 0); PG8_SCHED; PG8_LDA(At, 1, 0); PG8_STAGE(PG8_SA(0, 1), a2 + hstepA, voffA);
            PG8_WAIT_L(8); PG8_BAR; PG8_WAIT_L(0); PG8_MMA(0, 0, At, B0); PG8_BAR; PG8_SCHED;
            PG8_LDB(B1, 1, 1); PG8_STAGE(PG8_SB(1, 0), b3, voffB);
            PG8_BAR; PG8_WAIT_L(0); PG8_MMA(0, 1, At, B1); PG8_BAR;
            PG8_LDA(At, 1, 1); PG8_STAGE(PG8_SA(1, 0), a3, voffA);
            PG8_BAR; PG8_WAIT_L(0); PG8_MMA(1, 0, At, B0); PG8_BAR; PG8_SCHED;
            PG8_STAGE(PG8_SB(1, 1), b3 + hstepB, voffB);
            PG8_WAIT_V(6); PG8_BAR; PG8_MMA(1, 1, At, B1); PG8_BAR;
            }
            if constexpr (Epi::HAS_MID) { if (t + 2 == 4 || t + 2 == 10) E.mid(acc, cur, t + 2, wr, wc, fr, fq); }
        }
        if constexpr (ALIGN_EPI) { if (wr == 0) PG8_BAR; }
        if constexpr (!Epi::AFTER_DRAIN) { E(acc, cur, wr, wc, fr, fq); S.done(cur); }
        if (!has_next) break;
#pragma unroll
        for (int a = 0; a < 2; ++a)
#pragma unroll
            for (int b = 0; b < 2; ++b)
#pragma unroll
                for (int m = 0; m < 4; ++m)
#pragma unroll
                    for (int n = 0; n < 2; ++n) acc[a][b][m][n] = (f32x4){0.f, 0.f, 0.f, 0.f};
        cur = nxt; cA = nA; cB = nB; ++ui;
        if constexpr (ALIGN_EPI) { if (wr == 1) PG8_BAR; }
    }
    PG8_WAIT_V(0);
    if constexpr (!ALIGN_EPI) { if (wr == 0) PG8_BAR; }
    PG8_BAR;
#undef PG8_SA
#undef PG8_SB
#undef PG8_STAGE
#undef PG8_LDA
#undef PG8_LDB
#undef PG8_MMA
#undef PG8_WAIT_V
#undef PG8_WAIT_L
#undef PG8_BAR
#undef PG8_SCHED
}
}
namespace pg8 {
__device__ __forceinline__ float bflo(unsigned w) { return __uint_as_float(w << 16); }
__device__ __forceinline__ float bfhi(unsigned w) { return __uint_as_float(w & 0xffff0000u); }
__device__ __forceinline__ u32x4 pack8(const f32x4 a, const f32x4 b) { u32x4 w; w.x = cvt_pk_bf16(a[0], a[1]); w.y = cvt_pk_bf16(a[2], a[3]); w.z = cvt_pk_bf16(b[0], b[1]); w.w = cvt_pk_bf16(b[2], b[3]); return w; }
__device__ __forceinline__ void unpack8(const u32x4 w, f32x4& a, f32x4& b) { a = (f32x4){bflo(w.x), bfhi(w.x), bflo(w.y), bfhi(w.y)}; b = (f32x4){bflo(w.z), bfhi(w.z), bflo(w.w), bfhi(w.w)}; }
__device__ __forceinline__ float sigm(float x) { return __builtin_amdgcn_rcpf(1.f + __expf(-x)); }

struct EpiIn {
    static constexpr bool PERM = true, AFTER_DRAIN = false, HAS_MID = false;
    bf16_t* Z; bf16_t* SG; float* G32; const float* bias; const float* rowss;
    __device__ __forceinline__ void operator()(const f32x4 (&acc)[2][2][4][2], const Unit& u, int wr, int wc, int fr, int fq) const {
        const int row0 = u.pm * BM + wr * 64 + fr, colt = u.pn * BM + wc * 32 + 8 * fq;
        const float* bp = bias + (size_t)((u.pm * BM) >> 13) * 5888;
        float rs[2][4];
#pragma unroll
        for (int ai = 0; ai < 2; ++ai)
#pragma unroll
            for (int m = 0; m < 4; ++m) rs[ai][m] = rsqrtf(rowss[row0 + ai * HALF + m * 16] * (1.f / 1024.f) + 1e-6f);
#pragma unroll
        for (int bj = 0; bj < 2; ++bj) { const int col = colt + bj * HALF; const f32x4 b0 = *(const f32x4*)(bp + col), b1 = *(const f32x4*)(bp + col + 4);
#pragma unroll
            for (int ai = 0; ai < 2; ++ai)
#pragma unroll
                for (int m = 0; m < 4; ++m) { const size_t row = (size_t)(row0 + ai * HALF + m * 16); f32x4 v0 = acc[ai][bj][m][0] * rs[ai][m] + b0, v1 = acc[ai][bj][m][1] * rs[ai][m] + b1;
                    if (u.pn < 10) { *(u32x4*)(Z + row * 2560 + col) = pack8(v0, v1); }
                    else if (u.pn == 10) { if (col < 2560 + 16) { *(f32x4*)(G32 + row * 16 + (col - 2560)) = v0; *(f32x4*)(G32 + row * 16 + (col - 2560) + 4) = v1; } }
                    else {
#pragma unroll
                        for (int i = 0; i < 4; ++i) { v0[i] = fmaxf(sigm(v0[i]), 1e-18f); v1[i] = fmaxf(sigm(v1[i]), 1e-18f); }
                        *(u32x4*)(SG + (((size_t)(u.pm * 12 + (u.pn - 11)) * 256 + (row - (size_t)u.pm * BM)) * 256 + (col - u.pn * BM))) = pack8(v0, v1); } } }
    }
};
struct EpiMerge {
    static constexpr bool PERM = true, AFTER_DRAIN = false, HAS_MID = true;
    const bf16_t* SG; bf16_t* MG;
    __device__ __forceinline__ void mid(f32x4 (&acc)[2][2][4][2], const Unit& u, int kdone, int wr, int wc, int fr, int fq) const {
        const int noff = (kdone == 4) ? 0 : 1024;
        int fro = fr; asm volatile("" : "+v"(fro));
        const bf16_t* sp0 = SG + (size_t)(u.pm * 12 + (noff >> 8) + u.pn) * 65536 + (size_t)(wr * 64 + fro) * 256 + wc * 32 + 8 * fq;
#pragma unroll
        for (int aim = 0; aim < 4; ++aim) { const int ai = aim >> 1, mb = (aim & 1) * 2; u32x4 nv[4][2], dv[4][2];
#pragma unroll
            for (int m = mb; m < mb + 2; ++m)
#pragma unroll
                for (int bj = 0; bj < 2; ++bj) { const bf16_t* sp = sp0 + (ai * HALF + m * 16) * 256 + bj * HALF; nv[m][bj] = *(const u32x4*)(sp); dv[m][bj] = *(const u32x4*)(sp + 262144); }
#pragma unroll
            for (int m = mb; m < mb + 2; ++m)
#pragma unroll
                for (int bj = 0; bj < 2; ++bj) { f32x4 n0, n1, d0, d1; unpack8(nv[m][bj], n0, n1); unpack8(dv[m][bj], d0, d1);
#pragma unroll
                    for (int i = 0; i < 4; ++i) { acc[ai][bj][m][0][i] *= n0[i] * __builtin_amdgcn_rcpf(d0[i]); acc[ai][bj][m][1][i] *= n1[i] * __builtin_amdgcn_rcpf(d1[i]); } }
            asm volatile("" ::: "memory"); }
    }
    __device__ __forceinline__ void operator()(const f32x4 (&acc)[2][2][4][2], const Unit& u, int wr, int wc, int fr, int fq) const {
        const bf16_t* sp0 = SG + (size_t)(u.pm * 12 + 8 + u.pn) * 65536 + (size_t)(wr * 64 + fr) * 256 + wc * 32 + 8 * fq;
        bf16_t* mp0 = MG + (size_t)(u.pm * BM + wr * 64 + fr) * 1024 + u.pn * BM + wc * 32 + 8 * fq;
#pragma unroll
        for (int aim = 0; aim < 4; ++aim) { const int ai = aim >> 1, mb = (aim & 1) * 2; u32x4 gv[4][2];
#pragma unroll
            for (int m = mb; m < mb + 2; ++m)
#pragma unroll
                for (int bj = 0; bj < 2; ++bj) gv[m][bj] = *(const u32x4*)(sp0 + (ai * HALF + m * 16) * 256 + bj * HALF);
#pragma unroll
            for (int m = mb; m < mb + 2; ++m)
#pragma unroll
                for (int bj = 0; bj < 2; ++bj) { f32x4 g0, g1; unpack8(gv[m][bj], g0, g1);
                    *(u32x4*)(mp0 + (size_t)(ai * HALF + m * 16) * 1024 + bj * HALF) = pack8(acc[ai][bj][m][0] * g0, acc[ai][bj][m][1] * g1); }
            asm volatile("" ::: "memory"); }
    }
};
template <bool INBF> struct EpiRes {
    static constexpr bool PERM = true, AFTER_DRAIN = false, HAS_MID = false;
    const void* xin; bf16_t* xb; const float* gate; bf16_t* XT; const float* ng; const float* msc; float* rowss;
    __device__ __forceinline__ void operator()(const f32x4 (&acc)[2][2][4][2], const Unit& u, int wr, int wc, int fr, int fq) const {
        const int row0 = u.pm * BM + wr * 64 + fr, colt = u.pn * BM + wc * 32 + 8 * fq;
        const size_t bo = (size_t)((u.pm * BM) >> 13) * 6144; const float* gp = gate + bo; const float* mp = msc ? msc + bo : nullptr;
#pragma unroll
        for (int aim = 0; aim < 4; ++aim) { const int ai = aim >> 1, mb = (aim & 1) * 2; f32x4 xr[4][2][2];
#pragma unroll
            for (int m = mb; m < mb + 2; ++m)
#pragma unroll
                for (int bj = 0; bj < 2; ++bj) { const size_t off = (size_t)(row0 + ai * HALF + m * 16) * 1024 + colt + bj * HALF;
                    if (INBF) { const u32x4 w = *(const u32x4*)((const bf16_t*)xin + off); unpack8(w, xr[m][bj][0], xr[m][bj][1]); }
                    else { xr[m][bj][0] = *(const f32x4*)((const float*)xin + off); xr[m][bj][1] = *(const f32x4*)((const float*)xin + off + 4); } }
#pragma unroll
            for (int m = mb; m < mb + 2; ++m) { const int row = row0 + ai * HALF + m * 16; float ss = 0.f;
#pragma unroll
                for (int bj = 0; bj < 2; ++bj) { const int col = colt + bj * HALF; const size_t off = (size_t)row * 1024 + col;
                    const f32x4 g0 = *(const f32x4*)(gp + col), g1 = *(const f32x4*)(gp + col + 4);
                    const f32x4 x0 = xr[m][bj][0] + g0 * acc[ai][bj][m][0], x1 = xr[m][bj][1] + g1 * acc[ai][bj][m][1];
                    if (xb) *(u32x4*)(xb + off) = pack8(x0, x1);
                    ss += (x0[0] * x0[0] + x0[1] * x0[1]) + (x0[2] * x0[2] + x0[3] * x0[3]) + (x1[0] * x1[0] + x1[1] * x1[1]) + (x1[2] * x1[2] + x1[3] * x1[3]);
                    f32x4 n0 = *(const f32x4*)(ng + col), n1 = *(const f32x4*)(ng + col + 4);
                    if (mp) { n0 = n0 * (*(const f32x4*)(mp + col) + 1.f); n1 = n1 * (*(const f32x4*)(mp + col + 4) + 1.f); }
                    *(u32x4*)(XT + off) = pack8(x0 * n0, x1 * n1); }
                ss += __shfl_xor(ss, 16); ss += __shfl_xor(ss, 32); if (fq == 0) unsafeAtomicAdd(rowss + row, ss); }
            asm volatile("" ::: "memory"); }
    }
};
struct EpiFfn1 {
    static constexpr bool PERM = true, AFTER_DRAIN = false, HAS_MID = false;
    bf16_t* HID; const float* bias; const float* rowss;
    __device__ __forceinline__ void operator()(const f32x4 (&acc)[2][2][4][2], const Unit& u, int wr, int wc, int fr, int fq) const {
        const int row0 = u.pm * BM + wr * 64 + fr, hc = u.pn * 128 + wc * 32 + 8 * fq;
        const float* bp = bias + (size_t)((u.pm * BM) >> 13) * 5632 + u.pn * BM + wc * 32 + 8 * fq;
        const f32x4 ba0 = *(const f32x4*)(bp), ba1 = *(const f32x4*)(bp + 4), bb0 = *(const f32x4*)(bp + HALF), bb1 = *(const f32x4*)(bp + HALF + 4);
#pragma unroll
        for (int ai = 0; ai < 2; ++ai)
#pragma unroll
            for (int m = 0; m < 4; ++m) { const size_t row = (size_t)(row0 + ai * HALF + m * 16); f32x4 h0, h1; const float rs = rsqrtf(rowss[row] * (1.f / 1024.f) + 1e-6f);
#pragma unroll
                for (int i = 0; i < 4; ++i) { const float a = acc[ai][0][m][0][i] * rs + ba0[i], b = acc[ai][0][m][1][i] * rs + ba1[i];
                    h0[i] = a * sigm(a) * (acc[ai][1][m][0][i] * rs + bb0[i]); h1[i] = b * sigm(b) * (acc[ai][1][m][1][i] * rs + bb1[i]); }
                *(u32x4*)(HID + row * 2816 + hc) = pack8(h0, h1); }
    }
};
struct EpiGlu {
    static constexpr bool PERM = true, AFTER_DRAIN = false, HAS_MID = false;
    const bf16_t* YG; bf16_t* Z;
    __device__ __forceinline__ void operator()(const f32x4 (&acc)[2][2][4][2], const Unit& u, int wr, int wc, int fr, int fq) const {
        const int row0 = u.pm * BM + wr * 64 + fr, colt = wc * 32 + 8 * fq;
#pragma unroll
        for (int ai = 0; ai < 2; ++ai) { u32x4 yv[4][2];
#pragma unroll
            for (int m = 0; m < 4; ++m)
#pragma unroll
                for (int bj = 0; bj < 2; ++bj) yv[m][bj] = *(const u32x4*)(YG + (size_t)(row0 + ai * HALF + m * 16) * 1024 + 768 + colt + bj * HALF);
#pragma unroll
            for (int m = 0; m < 4; ++m)
#pragma unroll
                for (int bj = 0; bj < 2; ++bj) { f32x4 y0, y1; unpack8(yv[m][bj], y0, y1);
#pragma unroll
                    for (int i = 0; i < 4; ++i) { y0[i] *= sigm(acc[ai][bj][m][0][i]); y1[i] *= sigm(acc[ai][bj][m][1][i]); }
                    *(u32x4*)(Z + (size_t)(row0 + ai * HALF + m * 16) * 2560 + colt + bj * HALF) = pack8(y0, y1); }
            asm volatile("" ::: "memory"); }
    }
};
}
#include <hip/hip_bf16.h>
#include <cmath>
namespace attn_body {
using bf16=__hip_bfloat16;
using bf16x8=__attribute__((ext_vector_type(8)))short;
using s16x4=__attribute__((ext_vector_type(4)))short;
using f32x16=__attribute__((ext_vector_type(16)))float;
using f32x4v=__attribute__((ext_vector_type(4)))float;
using u32x4=__attribute__((ext_vector_type(4)))unsigned;
constexpr int BATCH=8,NHEAD=6,SEQ=8192,D=64,DM=2560;
constexpr int NW=8,QBLK=32,QB=QBLK*NW,KVBLK=64,NQB=SEQ/QB;
constexpr int ATTN_PITCH=DM, ATTN_UNIT_ROWS=QB;
__device__ __forceinline__ int crow(int r,int hi){return (r&3)+8*(r>>2)+4*hi;}
#define SBAR() __builtin_amdgcn_sched_barrier(0)
__device__ __forceinline__ void cmask(f32x16&p0,f32x16&p1,int jb,int qrel,int hi){
  const float NEG=-INFINITY; int d=qrel-4*hi-64*jb; asm volatile("":"+v"(d));
  #pragma unroll
  for(int r=0;r<16;++r){const int c=(r&3)+8*(r>>2); if(c>d)p0[r]=NEG; if(c+32>d)p1[r]=NEG;}
}

constexpr int NSLOT=3, SLOTB=8192;
constexpr int LDS_K=0, LDS_V=NSLOT*SLOTB, LDS_WS=2*NSLOT*SLOTB, LDS_OST=LDS_WS+NW*64*4, LDS_FB=LDS_OST+NW*4096, LDS_BYTES=LDS_FB+SEQ*4;
constexpr float C2=0.125f*1.4426950408889634f;
__device__ __forceinline__ void glds16(const void*gsrc,unsigned lds_dst){unsigned keep;
  asm volatile("s_mov_b32 %0, m0\n\ts_mov_b32 m0, %2\n\ts_nop 0\n\tglobal_load_lds_dwordx4 %1, off\n\ts_mov_b32 m0, %0":"=&s"(keep):"v"(gsrc),"s"(lds_dst):"memory");}
__device__ __forceinline__ float max3f(float a,float b,float c){float r;asm("v_max3_f32 %0, %1, %2, %3":"=v"(r):"v"(a),"v"(b),"v"(c));return r;}
__device__ __forceinline__ float max2f(float a,float b){float r;asm("v_max_f32_e32 %0, %1, %2":"=v"(r):"v"(a),"v"(b));return r;}
__device__ __forceinline__ float fadd_s(float a,float b){float r;asm("v_add_f32_e32 %0, %1, %2":"=v"(r):"v"(a),"v"(b));return r;}
__device__ __forceinline__ float fsub_s(float a,float b){float r;asm("v_sub_f32_e32 %0, %1, %2":"=v"(r):"v"(a),"v"(b));return r;}
typedef float f32x2_t __attribute__((ext_vector_type(2))); typedef __bf16 bf16x2_t __attribute__((ext_vector_type(2)));
__device__ __forceinline__ unsigned cvtpk_s(float lo,float hi){f32x2_t v={lo,hi};bf16x2_t b=__builtin_convertvector(v,bf16x2_t);return __builtin_bit_cast(unsigned,b);}
#define WAIT_BAR(N) asm volatile("s_waitcnt vmcnt(" #N ") lgkmcnt(0)\n\ts_barrier":::"memory")

__device__ __forceinline__ void qkt(f32x16&p0,f32x16&p1,const char*Kslot,const bf16x8*qr,int r32,int hi){
  const char*kb=Kslot+hi*1024+r32*16;
  #pragma unroll
  for(int d0=0;d0<4;++d0){
    const bf16x8 b0=*reinterpret_cast<const bf16x8*>(kb+d0*2048);
    const bf16x8 b1=*reinterpret_cast<const bf16x8*>(kb+d0*2048+512);
    {p0=__builtin_amdgcn_mfma_f32_32x32x16_bf16(b0,qr[d0],p0,0,0,0);p1=__builtin_amdgcn_mfma_f32_32x32x16_bf16(b1,qr[d0],p1,0,0,0);}}
}
typedef __attribute__((address_space(3))) const char* lds_cptr;
typedef short v4i16_t __attribute__((ext_vector_type(4)));
__device__ __forceinline__ void kload8(bf16x8*kf,lds_cptr kp){
  kf[0]=*(const __attribute__((address_space(3))) bf16x8*)(kp);      kf[1]=*(const __attribute__((address_space(3))) bf16x8*)(kp+512);
  kf[2]=*(const __attribute__((address_space(3))) bf16x8*)(kp+2048); kf[3]=*(const __attribute__((address_space(3))) bf16x8*)(kp+2560);
  kf[4]=*(const __attribute__((address_space(3))) bf16x8*)(kp+4096); kf[5]=*(const __attribute__((address_space(3))) bf16x8*)(kp+4608);
  kf[6]=*(const __attribute__((address_space(3))) bf16x8*)(kp+6144); kf[7]=*(const __attribute__((address_space(3))) bf16x8*)(kp+6656);
}
__device__ __forceinline__ void kload2(bf16x8*kf,lds_cptr kp,int j){ kf[2*j]=*(const __attribute__((address_space(3))) bf16x8*)(kp+j*2048); kf[2*j+1]=*(const __attribute__((address_space(3))) bf16x8*)(kp+j*2048+512); }
__device__ __forceinline__ s16x4 vtr(lds_cptr p){ return __builtin_bit_cast(s16x4,__builtin_amdgcn_ds_read_tr16_b64_v4i16((__attribute__((address_space(3))) v4i16_t*)p)); }
__device__ __forceinline__ float rowmax(const f32x16&p0,const f32x16&p1){
  float a=max3f(p0[0],p0[1],p1[0]),b=max3f(p0[2],p0[3],p1[1]);a=max3f(a,p1[2],p1[3]);
  #pragma unroll
  for(int r=4;r<16;r+=4){a=max3f(a,p0[r],p0[r+1]);b=max3f(b,p0[r+2],p0[r+3]);a=max3f(a,p1[r],p1[r+1]);b=max3f(b,p1[r+2],p1[r+3]);}
  const float m=max2f(a,b);
  auto rr=__builtin_amdgcn_permlane32_swap(__float_as_uint(m),__float_as_uint(m),false,false);
  return max2f(__uint_as_float(rr[0]),__uint_as_float(rr[1]));
}
__device__ __forceinline__ void pv(f32x16*o,int vb,bf16x8 pa0,bf16x8 pa1,bf16x8 pa2,bf16x8 pa3){
  #pragma unroll
  for(int d0=0;d0<2;++d0){s16x4 lo[4],hi[4];
    #pragma unroll
    for(int ks=0;ks<4;++ks){
      asm volatile("ds_read_b64_tr_b16 %0,%1 offset:%c2":"=&v"(lo[ks]):"v"(vb),"i"(d0*4096+ks*1024):"memory");
      asm volatile("ds_read_b64_tr_b16 %0,%1 offset:%c2":"=&v"(hi[ks]):"v"(vb),"i"(d0*4096+ks*1024+512):"memory");}
    asm volatile("s_waitcnt lgkmcnt(0)":::"memory");SBAR();
    #define PK(k) (bf16x8){lo[k][0],lo[k][1],lo[k][2],lo[k][3],hi[k][0],hi[k][1],hi[k][2],hi[k][3]}
    o[d0]=__builtin_amdgcn_mfma_f32_32x32x16_bf16(pa0,PK(0),o[d0],0,0,0);
    o[d0]=__builtin_amdgcn_mfma_f32_32x32x16_bf16(pa1,PK(1),o[d0],0,0,0);
    o[d0]=__builtin_amdgcn_mfma_f32_32x32x16_bf16(pa2,PK(2),o[d0],0,0,0);
    o[d0]=__builtin_amdgcn_mfma_f32_32x32x16_bf16(pa3,PK(3),o[d0],0,0,0);
    #undef PK
  }
}

#ifndef ATTN_STORE16
#define ATTN_STORE16(p,v) (*(u32x4*)(p)=(v))
#endif
template<int THRL> __device__ __forceinline__ void attn_unit(int b,int h,int qb,int t0,const bf16*Q,const bf16*__restrict__ K,const bf16*__restrict__ V,bf16*O,const float*__restrict__ FBrow,char*shm){
  int tid_o=threadIdx.x; asm volatile("":"+v"(tid_o)); const int tid=tid_o,lane=tid&63,r32=lane&31,hi=lane>>5; const int wid=__builtin_amdgcn_readfirstlane(tid>>6);
  const long rowbase=(long)b*SEQ; const int q0=qb*QB;
  const bf16*Qw=Q+(rowbase+q0+wid*QBLK)*DM+h*D;
  const bf16*Kh=K+(rowbase+(long)t0*KVBLK)*DM+h*D,*Vh=V+(rowbase+(long)t0*KVBLK)*DM+h*D;
  const lds_cptr shm3=(lds_cptr)shm;
  const unsigned lds0=(unsigned)(uintptr_t)shm;
  float*wsf=(float*)(shm+LDS_WS)+wid*64;
  const bf16*ksrc=Kh+(long)lane*DM+wid*8;
  const bf16*vsrc=Vh+(long)(16*(wid&3)+(lane>>2))*DM+(wid>>2)*32+(lane&3)*8;
  const unsigned kdst=lds0+LDS_K+wid*1024, vdst=lds0+LDS_V+wid*1024;
  #define DMA_K(t,slot) glds16(ksrc+(long)(t)*KVBLK*DM,(unsigned)__builtin_amdgcn_readfirstlane(kdst+(slot)))
  #define DMA_V(t,slot) glds16(vsrc+(long)(t)*KVBLK*DM,(unsigned)__builtin_amdgcn_readfirstlane(vdst+(slot)))
  const int vb0=(int)(lds0+LDS_V)+((lane>>4)&1)*32+(lane&3)*8+(4*hi+((lane&15)>>2))*64;
  const char*Kbase=shm+LDS_K; bf16x8 kf[8];
  const lds_cptr kp0=shm3+LDS_K+hi*1024+r32*16; const lds_cptr vp0=shm3+LDS_V+((lane>>4)&1)*32+(lane&3)*8+(4*hi+((lane&15)>>2))*64;
  const int NT=(q0+QB)/KVBLK-t0;
  typedef __attribute__((address_space(3))) const f32x4v* lds_f4p;
  { __attribute__((address_space(3))) f32x4v* fl=(__attribute__((address_space(3))) f32x4v*)(shm3+LDS_FB); const int n4=(q0+QB-t0*KVBLK)>>2;
    for(int i=tid;i<n4;i+=512)fl[i]=*(const f32x4v*)(FBrow+t0*KVBLK+4*i); }
  const lds_cptr flb=shm3+LDS_FB+16*hi;
  #define BIASF1(C0,t,OFF) do{ const lds_cptr fp_=flb+256*(t)+(OFF); _Pragma("unroll") for(int j_=0;j_<4;++j_){ const f32x4v a_=*(lds_f4p)(fp_+32*j_); C0[4*j_]=a_[0];C0[4*j_+1]=a_[1];C0[4*j_+2]=a_[2];C0[4*j_+3]=a_[3]; } }while(0)
  #define BIASFILL(C0,C1,t) do{ BIASF1(C0,t,0); BIASF1(C1,t,128); }while(0)
  DMA_K(0,0);DMA_V(0,0);DMA_K(1,SLOTB);
  bf16x8 qr[4];
  #pragma unroll
  for(int d0=0;d0<4;++d0)qr[d0]=*reinterpret_cast<const bf16x8*>(&Qw[(long)r32*DM+d0*16+hi*8]);
  float mhat=0.f,l_reg=0.f;f32x16 o[2];o[0]=f32x16{};o[1]=f32x16{};
  const int qrel=wid*QBLK+r32;
  #define CMASK(P0,P1,t) do{int jb_=(t)-(NT-4); if(jb_>=0)cmask(P0,P1,jb_,qrel,hi);}while(0)
  bool resc=false;
  #define START(P0,P1) do{ const float rm=rowmax(P0,P1); resc=false; \
    { const float dl=rm; mhat=fadd_s(mhat,dl); \
      _Pragma("unroll") for(int r=0;r<16;++r){P0[r]=fsub_s(P0[r],dl);P1[r]=fsub_s(P1[r],dl);} \
      } \
    _Pragma("unroll") for(int r=0;r<16;++r)P0[r]=__builtin_amdgcn_exp2f(P0[r]); }while(0)
  #define RESC() do{ if(resc){ asm volatile("s_waitcnt lgkmcnt(0)":::"memory"); \
      _Pragma("unroll") for(int d_=0;d_<2;++d_) _Pragma("unroll") for(int r=0;r<16;++r)o[d_][r]*=wsf[crow(r,hi)]; } }while(0)
  f32x16 pA0,pA1,pB0,pB1;
  int sl_prev=0,sl_cur=0,sl_next=SLOTB;
  #define ROT() do{sl_prev=sl_cur;sl_cur=sl_next;sl_next=(sl_next==(NSLOT-1)*SLOTB)?0:sl_next+SLOTB;}while(0)
  DMA_K(2,2*SLOTB);
  WAIT_BAR(3);
  BIASFILL(pA0,pA1,0); qkt(pA0,pA1,Kbase,qr,r32,hi);asm volatile("s_nop 15\n\ts_nop 7":"+v"(pA0),"+v"(pA1));CMASK(pA0,pA1,0);
  START(pA0,pA1);
  _Pragma("unroll") for(int r=0;r<16;++r)pA1[r]=__builtin_amdgcn_exp2f(pA1[r]);
  WAIT_BAR(0);
  DMA_K(3,0);DMA_V(1,SLOTB);
  ROT();
  kload8(kf,kp0+sl_cur);
  WAIT_BAR(2);
  s16x4 vlo[8],vhi[8]; u32x4 pw0,pw1,pw2,pw3;
  #define PKW(P,B) cvtpk_s(P[B],P[B+1])
  #define PAF(k) __builtin_bit_cast(bf16x8,pw##k)
  #define VFR(i) (bf16x8){vlo[i][0],vlo[i][1],vlo[i][2],vlo[i][3],vhi[i][0],vhi[i][1],vhi[i][2],vhi[i][3]}
  #define PIN(x) asm volatile("":"+v"(x))
  #define MX3(a,b,c) __builtin_fmaxf(__builtin_fmaxf((a),(b)),(c))
  #define GAPA(MF,A0,A1,A2,A3,W0,W1,PW) do{ MF; sacc+=A0; sacc+=A1; sacc+=A2; sacc+=A3; PIN(sacc); W0; W1; PIN(PW); SBAR(); }while(0)
  #define EX(v) __builtin_amdgcn_exp2f(v)
  #define GAPB(MF,X,B) do{ MF; X[B]=EX(X[B]-mhat); X[B+1]=EX(X[B+1]-mhat); X[B+2]=EX(X[B+2]-mhat); X[B+3]=EX(X[B+3]-mhat); PIN(X); SBAR(); }while(0)
  #define VRD(i) do{ vlo[i]=vtr(vp_+(((i)>>2)*4096+((i)&3)*1024)); vhi[i]=vtr(vp_+(((i)>>2)*4096+((i)&3)*1024+512)); }while(0)
  #define KRD(G,j) do{ if(G){ kload2(kf,kp0+sl_next,j); SBAR(); } }while(0)
  #define STEP(C0,C1,P0,P1,t,GK,GV,GL) do{ SBAR(); BIASF1(C0,t,0); SBAR(); \
    const lds_cptr vp_=vp0+sl_prev; \
    VRD(0); SBAR(); float sacc=(P0[0]+P0[1]); \
    GAPA(C0=__builtin_amdgcn_mfma_f32_32x32x16_bf16(kf[0],qr[0],C0,0,0,0), P0[2],P0[3],P0[4],P0[5],     pw0[0]=PKW(P0,0), pw0[1]=PKW(P0,2), pw0); \
    BIASF1(C1,t,128); VRD(4); SBAR(); GAPA(C1=__builtin_amdgcn_mfma_f32_32x32x16_bf16(kf[1],qr[0],C1,0,0,0), P0[6],P0[7],P0[8],P0[9],     pw0[2]=PKW(P0,4), pw0[3]=PKW(P0,6), pw0); \
    VRD(1); SBAR(); GAPA(C0=__builtin_amdgcn_mfma_f32_32x32x16_bf16(kf[2],qr[1],C0,0,0,0),   P0[10],P0[11],P0[12],P0[13], pw1[0]=PKW(P0,8), pw1[1]=PKW(P0,10), pw1); \
    VRD(5); SBAR(); GAPA(C1=__builtin_amdgcn_mfma_f32_32x32x16_bf16(kf[3],qr[1],C1,0,0,0),   P0[14],P0[15],P1[0],P1[1],   pw1[2]=PKW(P0,12),pw1[3]=PKW(P0,14), pw1); \
    VRD(2); SBAR(); GAPA(C0=__builtin_amdgcn_mfma_f32_32x32x16_bf16(kf[4],qr[2],C0,0,0,0),   P1[2],P1[3],P1[4],P1[5],     pw2[0]=PKW(P1,0), pw2[1]=PKW(P1,2), pw2); \
    VRD(6); SBAR(); GAPA(C1=__builtin_amdgcn_mfma_f32_32x32x16_bf16(kf[5],qr[2],C1,0,0,0),   P1[6],P1[7],P1[8],P1[9],     pw2[2]=PKW(P1,4), pw2[3]=PKW(P1,6), pw2); \
    VRD(3); SBAR(); GAPA(C0=__builtin_amdgcn_mfma_f32_32x32x16_bf16(kf[6],qr[3],C0,0,0,0),   P1[10],P1[11],P1[12],P1[13], pw3[0]=PKW(P1,8), pw3[1]=PKW(P1,10), pw3); \
    VRD(7); SBAR(); GAPA(C1=__builtin_amdgcn_mfma_f32_32x32x16_bf16(kf[7],qr[3],C1,0,0,0),   P1[14],P1[15],0.f,0.f,       pw3[2]=PKW(P1,12),pw3[3]=PKW(P1,14), pw3); \
    l_reg+=sacc; \
    if(GK){DMA_K((t)+3,sl_cur);} if(GV){DMA_V((t)+1,sl_next);} \
    CMASK(C0,C1,t); \
    { float a=MX3(C0[0],C0[1],C1[0]),b=MX3(C0[2],C0[3],C1[1]); a=MX3(a,C1[2],C1[3]); \
      _Pragma("unroll") for(int r=4;r<16;r+=4){a=MX3(a,C0[r],C0[r+1]);b=MX3(b,C0[r+2],C0[r+3]);a=MX3(a,C1[r],C1[r+1]);b=MX3(b,C1[r+2],C1[r+3]);} \
      float rm=__builtin_fmaxf(a,b); { auto rr=__builtin_amdgcn_permlane32_swap(__float_as_uint(rm),__float_as_uint(rm),false,false); rm=__builtin_fmaxf(__uint_as_float(rr[0]),__uint_as_float(rr[1])); } \
      resc=false; \
      if(__builtin_expect(__any(rm>mhat+(float)THRL),0)){ const float dl=__builtin_fmaxf(rm-mhat,0.f); mhat+=dl; \
        const float f=__builtin_amdgcn_exp2f(-dl); l_reg*=f; if(hi==0)wsf[r32]=f; resc=true; } } \
    SBAR(); \
    GAPB(o[0]=__builtin_amdgcn_mfma_f32_32x32x16_bf16(PAF(0),VFR(0),o[0],0,0,0), C0,0); \
    GAPB(o[1]=__builtin_amdgcn_mfma_f32_32x32x16_bf16(PAF(0),VFR(4),o[1],0,0,0), C0,4); \
    KRD(GL,0); GAPB(o[0]=__builtin_amdgcn_mfma_f32_32x32x16_bf16(PAF(1),VFR(1),o[0],0,0,0), C0,8); \
    KRD(GL,1); GAPB(o[1]=__builtin_amdgcn_mfma_f32_32x32x16_bf16(PAF(1),VFR(5),o[1],0,0,0), C0,12); \
    KRD(GL,2); GAPB(o[0]=__builtin_amdgcn_mfma_f32_32x32x16_bf16(PAF(2),VFR(2),o[0],0,0,0), C1,0); \
    KRD(GL,3); GAPB(o[1]=__builtin_amdgcn_mfma_f32_32x32x16_bf16(PAF(2),VFR(6),o[1],0,0,0), C1,4); \
    GAPB(o[0]=__builtin_amdgcn_mfma_f32_32x32x16_bf16(PAF(3),VFR(3),o[0],0,0,0), C1,8); \
    GAPB(o[1]=__builtin_amdgcn_mfma_f32_32x32x16_bf16(PAF(3),VFR(7),o[1],0,0,0), C1,12); \
    }while(0)
  int t=1;
  #undef CMASK
  #define CMASK(P0,P1,t) do{}while(0)
  for(;t+5<NT;t+=2){
    STEP(pB0,pB1,pA0,pA1,t,true,true,true);     WAIT_BAR(2); RESC(); ROT();
    STEP(pA0,pA1,pB0,pB1,t+1,true,true,true);   WAIT_BAR(2); RESC(); ROT();
  }
  #undef CMASK
  #define CMASK(P0,P1,t) do{int jb_=(t)-(NT-4); if(jb_>=0)cmask(P0,P1,jb_,qrel,hi);}while(0)
  #define ENDW(tt) do{ if((tt)+3<NT){WAIT_BAR(2);} else if((tt)+2<NT){WAIT_BAR(1);} else {WAIT_BAR(0);} }while(0)
  for(;t+1<NT;t+=2){
    STEP(pB0,pB1,pA0,pA1,t,(t+3<NT),(t+1<NT),(t+1<NT));       ENDW(t);   RESC(); ROT();
    STEP(pA0,pA1,pB0,pB1,t+1,(t+4<NT),(t+2<NT),(t+2<NT));     ENDW(t+1); RESC(); ROT();
  }
  STEP(pB0,pB1,pA0,pA1,NT-1,false,false,false); RESC();
  { float sacc=pB0[0]+pB0[1]; _Pragma("unroll") for(int r=2;r<16;++r)sacc+=pB0[r]; _Pragma("unroll") for(int r=0;r<16;++r)sacc+=pB1[r]; l_reg+=sacc;
    pw0=(u32x4){PKW(pB0,0),PKW(pB0,2),PKW(pB0,4),PKW(pB0,6)};pw1=(u32x4){PKW(pB0,8),PKW(pB0,10),PKW(pB0,12),PKW(pB0,14)};pw2=(u32x4){PKW(pB1,0),PKW(pB1,2),PKW(pB1,4),PKW(pB1,6)};pw3=(u32x4){PKW(pB1,8),PKW(pB1,10),PKW(pB1,12),PKW(pB1,14)};
    SBAR(); pv(o,vb0+sl_cur,PAF(0),PAF(1),PAF(2),PAF(3)); }
  #undef PKW
  #undef PAF
  #undef VFR
  #undef PIN
  #undef MX3
  #undef GAPA
  #undef GAPB
  #undef EX
  #undef VRD
  #undef KRD
  #undef STEP
  #undef ENDW
  {auto rr=__builtin_amdgcn_permlane32_swap(__float_as_uint(l_reg),__float_as_uint(l_reg),false,false);l_reg=__uint_as_float(rr[0])+__uint_as_float(rr[1]);}
  if(hi==0)wsf[32+r32]=l_reg;asm volatile("s_waitcnt lgkmcnt(0)":::"memory");
  float rli[16];
  #pragma unroll
  for(int r=0;r<16;++r)rli[r]=__builtin_amdgcn_rcpf(wsf[32+crow(r,hi)]);
  bf16*Ow=O+(rowbase+q0+wid*QBLK)*DM+h*D;
  { int r32o=r32; asm volatile("":"+v"(r32o)); bf16*stg=(bf16*)(shm+LDS_OST)+wid*2048;
    #pragma unroll
    for(int r=0;r<16;++r){const int orow=crow(r,hi);
      #pragma unroll
      for(int d0=0;d0<2;++d0)stg[orow*64+d0*32+r32o]=__float2bfloat16(o[d0][r]*rli[r]);}
    asm volatile("s_waitcnt lgkmcnt(0)":::"memory");
    #pragma unroll
    for(int i=0;i<4;++i){const int row=i*8+(lane>>3),ch=lane&7; const u32x4 v=*(const u32x4*)(stg+row*64+ch*8); ATTN_STORE16(Ow+(long)row*DM+ch*8,v);} }
  asm volatile("s_waitcnt lgkmcnt(0)\n\ts_barrier":::"memory");
  #undef DMA_K
  #undef DMA_V
  #undef CMASK
  #undef START
  #undef RESC
  #undef ROT
  #undef BIASFILL
  #undef BIASF1
}
constexpr int ATTN_LDS_BYTES=LDS_BYTES;
#undef SBAR
#undef WAIT_BAR
}
namespace cg = cooperative_groups;
#define LAS __attribute__((address_space(3)))
typedef unsigned short bf16_t;
typedef short h8 __attribute__((ext_vector_type(8)));
typedef float f4 __attribute__((ext_vector_type(4)));
typedef unsigned u4 __attribute__((ext_vector_type(4)));
typedef unsigned u2 __attribute__((ext_vector_type(2)));

#ifndef PROBE_MASK
#define PROBE_MASK 0
#endif
#ifndef MK_PER_PHASE
#define MK_PER_PHASE 0
#endif
constexpr int NTOK = 65536, SEQL = 8192, NBAT = 8, DMODEL = 1024;
constexpr int ZP = 2560, SGP = 3072, CPITCH = 1024, NINP = 5888, NIN = 5646, FFH = 2816;
constexpr int ZC_S5 = 0, ZC_MO = 256, ZC_FQ = 640, ZC_MQK = 1024, ZC_MV = 1408, ZC_FK = 1792, ZC_FV = 2176;
constexpr float EPSN = 1e-6f, LOG2E = 1.4426950408889634f, C2Q = 0.125f * 1.4426950408889634f;
constexpr int LDS_TOTAL = 147456, LDS_MISC = 147456 - 64;
constexpr int NPH_LAYER = 9, NPHASES = 2 + 2 * NPH_LAYER + 1;

constexpr size_t MiB = 1u << 20;
constexpr size_t WS_WIN = 1 * MiB, WS_W13 = 24 * MiB, WS_W2 = 46 * MiB, WS_WMG = 57 * MiB, WS_WOUT = 61 * MiB, WS_KMAT = 65 * MiB, WS_W1S = 69 * MiB, WS_W3S = 71 * MiB,
                 WS_WGLU = 73 * MiB, WS_WQK = 73 * MiB + 512 * 1024, WS_BIASP = 74 * MiB, WS_MODV = 74 * MiB + 128 * 1024, WS_LAM = 75 * MiB, WS_BBAR = 75 * MiB + 512 * 1024,
                 WS_Z = 77 * MiB, WS_SG = 397 * MiB, WS_C = 781 * MiB, WS_G32 = 909 * MiB, WS_ST = 913 * MiB, WS_ES = 950 * MiB, WS_XS = 982 * MiB,
                 WS_FB = 998 * MiB, WS_ABUF = 1000 * MiB, WS_BBUF = 1001 * MiB, WS_MS = 1002 * MiB, WS_AMX = 1002 * MiB + 64 * 1024, WS_END = 1003 * MiB,
                 WS_NRM = 1002 * MiB + 128 * 1024, WS_AQ = 1002 * MiB + 192 * 1024, WS_ROWSS4 = 1002 * MiB + 256 * 1024, WS_ROWSS = 76 * MiB, WS_BIASB_IN = 74 * MiB + 512 * 1024, WS_BIASB_F = 64 * 1024, WS_XT2 = 429 * MiB;

struct Args { const float* in[30]; float* out; unsigned char* ws; int ph_lo, ph_hi; };

__device__ __forceinline__ unsigned f2bf(float f) { unsigned u = __float_as_uint(f); return (u + 0x7fffu + ((u >> 16) & 1u)) >> 16; }
__device__ __forceinline__ unsigned pk2(float lo, float hi) { return f2bf(lo) | (f2bf(hi) << 16); }
__device__ __forceinline__ float bf2f(unsigned short h) { return __uint_as_float(((unsigned)h) << 16); }
__device__ __forceinline__ float blo(unsigned w) { return __uint_as_float(w << 16); }
__device__ __forceinline__ float bhi(unsigned w) { return __uint_as_float(w & 0xffff0000u); }
__device__ __forceinline__ float sigmf(float x) { return __builtin_amdgcn_rcpf(1.f + __expf(-x)); }
__device__ __forceinline__ float logsig(float x) { return fminf(x, 0.f) - log1pf(__expf(-fabsf(x))); }
__device__ __forceinline__ float wave_sum(float v) {
#pragma unroll
    for (int o = 1; o < 64; o <<= 1) v += __shfl_xor(v, o);
    return v;
}
#define LDS_BARRIER() asm volatile("s_waitcnt lgkmcnt(0)\n\ts_barrier" ::: "memory")
#define MFMA16(a, b, c) __builtin_amdgcn_mfma_f32_16x16x32_bf16((a), (b), (c), 0, 0, 0)

__device__ __forceinline__ int win_src(int r, float& sc) {
    sc = 1.f;
    if (r < 256) return r;
    if (r < 640) return 1024 + (r - 256);
    if (r < 1024) { sc = C2Q; return 1416 + (r - 640); }
    if (r < 1408) return 256 + (r - 1024);
    if (r < 1792) return 640 + (r - 1408);
    if (r < 2176) return 1800 + (r - 1792);
    if (r < 2560) return 2184 + (r - 2176);
    if (r < 2816) { const int j = r - 2560; if (j < 8) return 1408 + j; if (j < 14) return 2568 + (j - 8); return -1; }
    return 2574 + (r - 2816);
}
__device__ __forceinline__ void tr_tile(const float* __restrict__ W, int ldw, int ksrc0, int srccol, float scale, bf16_t* WT, int ldt, int destrow0, int kdst0, LAS float* scr, int lane) {
#pragma unroll
    for (int i = 0; i < 32; ++i) { const int kk = 2 * i + (lane >> 5); scr[kk * 33 + (lane & 31)] = (srccol >= 0) ? W[(size_t)(ksrc0 + kk) * ldw + srccol] * scale : 0.f; }
    asm volatile("s_waitcnt lgkmcnt(0)" ::: "memory");
    const int c = lane & 7;
#pragma unroll
    for (int j = 0; j < 4; ++j) { const int n = (lane >> 3) + 8 * j; const LAS float* s = scr + (8 * c) * 33 + n;
        u4 o; o.x = pk2(s[0 * 33], s[1 * 33]); o.y = pk2(s[2 * 33], s[3 * 33]); o.z = pk2(s[4 * 33], s[5 * 33]); o.w = pk2(s[6 * 33], s[7 * 33]);
        *(u4*)(WT + (size_t)(destrow0 + n) * ldt + kdst0 + 8 * c) = o; }
    asm volatile("s_waitcnt lgkmcnt(0)" ::: "memory");
}
__device__ __forceinline__ void lam_pow(float are, float aim, float dt, int d, float& lr, float& li) {
    const float mag = expf((float)d * dt * are); const float ang = (float)d * dt * aim;
    float rev = ang * 0.15915494309189535f; rev -= rintf(rev); const float th = rev * 6.283185307179586f;
    lr = mag * cosf(th); li = mag * sinf(th);
}
__device__ __forceinline__ void prologue_a(const Args& A, LAS unsigned char* lds, int tid, int lane, int wave) {
    unsigned char* ws = A.ws;
    const int G = gridDim.x, gw = blockIdx.x * 8 + wave, NGW = G * 8;
    LAS float* scr = (LAS float*)(lds + wave * 8704);
    constexpr int I_WIN = 184 * 16, I_W13 = 176 * 16, I_W2 = 32 * 44, I_WMG = 32 * 16, I_WOUT = 32 * 16, I_GLU = 8 * 4, I_L = I_WIN + I_W13 + I_W2 + I_WMG + I_WOUT + I_GLU;
    for (int it = gw; it < 2 * I_L; it += NGW) {
        const int l = it / I_L; int r = it % I_L; const int j = lane & 31;
        if (r < I_WIN) { const int grp = r % 184, kb = r / 184; float sc; const int src = win_src(grp * 32 + j, sc);
            tr_tile(A.in[6] + (size_t)l * 1024 * NIN, NIN, kb * 64, src, sc, (bf16_t*)(ws + WS_WIN) + (size_t)l * NINP * 1024, 1024, grp * 32, kb * 64, scr, lane); continue; } r -= I_WIN;
        if (r < I_W13) { const int grp = r % 176, kb = r / 176; const int dr = grp * 32, pn = dr >> 8, s = (dr >> 7) & 1, jj = dr & 127;
            tr_tile(A.in[s ? 27 : 26] + (size_t)l * 1024 * FFH, FFH, kb * 64, pn * 128 + jj + j, 1.f, (bf16_t*)(ws + WS_W13) + (size_t)l * 5632 * 1024, 1024, dr, kb * 64, scr, lane); continue; } r -= I_W13;
        if (r < I_W2) { const int grp = r % 32, kb = r / 32;
            tr_tile(A.in[28] + (size_t)l * FFH * 1024, 1024, kb * 64, grp * 32 + j, 1.f, (bf16_t*)(ws + WS_W2) + (size_t)l * 1024 * FFH, FFH, grp * 32, kb * 64, scr, lane); continue; } r -= I_W2;
        if (r < I_WMG) { const int grp = r % 32, kb = r / 32; const int k0 = kb * 64; const float* W; int ks;
            if (k0 < 256) { W = A.in[22] + (size_t)l * 256 * 1024; ks = k0; } else if (k0 < 640) { W = A.in[23] + (size_t)l * 384 * 1024; ks = k0 - 256; } else { W = A.in[24] + (size_t)l * 384 * 1024; ks = k0 - 640; }
            tr_tile(W, 1024, ks, grp * 32 + j, 1.f, (bf16_t*)(ws + WS_WMG) + (size_t)l * 1024 * 1024, 1024, grp * 32, k0, scr, lane); continue; } r -= I_WMG;
        if (r < I_WOUT) { const int grp = r % 32, kb = r / 32;
            tr_tile(A.in[25] + (size_t)l * 1024 * 1024, 1024, kb * 64, grp * 32 + j, 1.f, (bf16_t*)(ws + WS_WOUT) + (size_t)l * 1024 * 1024, 1024, grp * 32, kb * 64, scr, lane); continue; } r -= I_WOUT;
        { const int grp = r % 8, kb = r / 8;
            tr_tile(A.in[16] + (size_t)l * 256 * 256, 256, kb * 64, grp * 32 + j, 1.f, (bf16_t*)(ws + WS_WGLU) + (size_t)l * 256 * 256, 256, grp * 32, kb * 64, scr, lane); }
    }
    constexpr int E_BIAS = 2 * NINP, E_WQK = 2 * 4 * 192 * 96, E_LAM = 2 * 16 * 64 * 17, E_BB = 2 * 16 * 64 * 16, E_ALL = E_BIAS + E_WQK + E_LAM + E_BB;
    for (int e = blockIdx.x * 512 + tid; e < E_ALL; e += G * 512) {
        int r = e;
        if (r < E_BIAS) { const int l = r / NINP, d = r % NINP; float sc; const int src = win_src(d, sc); ((float*)(ws + WS_BIASP))[r] = (src >= 0) ? A.in[7][(size_t)l * NIN + src] * sc : 0.f; continue; } r -= E_BIAS;
        if (r < E_WQK) { const int d = r % 96, ep = (r / 96) % 192, lh = r / (96 * 192);
            const float v = (ep < 96) ? A.in[19][((size_t)lh * 96 + d) * 96 + ep] : A.in[20][((size_t)lh * 96 + d) * 96 + (ep - 96)] * 0.10206207261596577f;
            ((bf16_t*)(ws + WS_WQK))[r] = (bf16_t)f2bf(v); continue; } r -= E_WQK;
        if (r < E_LAM) { const int d = r % 17, lgn = r / 17, lg = lgn / 64; float lr, li; lam_pow(A.in[8][lgn], A.in[9][lgn], expf(A.in[10][lg]), d, lr, li);
            ((float*)(ws + WS_LAM))[2 * r] = lr; ((float*)(ws + WS_LAM))[2 * r + 1] = li; continue; } r -= E_LAM;
        { const int lgn = r / 16, lg = lgn / 64; const float are = A.in[8][lgn], aim = A.in[9][lgn]; float lr, li; lam_pow(are, aim, expf(A.in[10][lg]), 1, lr, li);
            const float p = lr - 1.f, q = li, den = are * are + aim * aim, cr = (p * are + q * aim) / den, ci = (q * are - p * aim) / den;
            const float br = A.in[11][r], bi = A.in[12][r];
            ((float*)(ws + WS_BBAR))[2 * r] = cr * br - ci * bi; ((float*)(ws + WS_BBAR))[2 * r + 1] = cr * bi + ci * br; }
    }
    for (int e = blockIdx.x * 512 + tid; e < 3 * 65536 / 4; e += G * 512) ((f4*)(ws + WS_ROWSS))[65536 / 4 + e] = (f4){0.f, 0.f, 0.f, 0.f};
    for (int e = blockIdx.x * 512 + tid; e < 65536 / 4; e += G * 512) ((f4*)(ws + WS_ROWSS4))[e] = (f4){0.f, 0.f, 0.f, 0.f};
    if (blockIdx.x == 0 && tid < 192) ((unsigned*)(ws + WS_NRM))[tid] = 0u;
    if (blockIdx.x == 1 && tid < 16) ((unsigned*)(ws + WS_AQ))[tid * 64] = 0u;
    __syncthreads();
    LAS float* cf = (LAS float*)lds; LAS float* part = (LAS float*)(lds + 32768);
    if ((int)blockIdx.x < 192) { for (int i = tid; i < 8192; i += 512) { const float c = A.in[1][i]; cf[i] = c * sigmf(c); } }
    __syncthreads();
    for (int it = blockIdx.x; it < 192; it += G) {
        const int l = it / 96, col = (it % 96) * 64 + lane; float acc[8];
#pragma unroll
        for (int b = 0; b < 8; ++b) acc[b] = 0.f;
        const float* wp = A.in[2] + ((size_t)l * 1024 + wave * 128) * 6144 + col;
#pragma unroll 16
        for (int k = 0; k < 128; ++k) { const float wv = wp[(size_t)k * 6144];
#pragma unroll
            for (int b = 0; b < 8; ++b) acc[b] += cf[b * 1024 + wave * 128 + k] * wv; }
#pragma unroll
        for (int b = 0; b < 8; ++b) part[(wave * 8 + b) * 64 + lane] = acc[b];
        __syncthreads();
        { const int b = tid >> 6; float s = 0.f;
#pragma unroll
          for (int w = 0; w < 8; ++w) s += part[(w * 8 + b) * 64 + lane];
          ((float*)(ws + WS_MODV))[((size_t)l * 8 + b) * 6144 + col] = s + A.in[3][(size_t)l * 6144 + col]; }
        __syncthreads();
    }
}
__device__ __forceinline__ void prologue_b(const Args& A, int tid) {
    unsigned char* ws = A.ws; const int G = gridDim.x;
    const float* LAM = (const float*)(ws + WS_LAM); const float* BB = (const float*)(ws + WS_BBAR);
    bf16_t* KM = (bf16_t*)(ws + WS_KMAT); bf16_t* W1 = (bf16_t*)(ws + WS_W1S); bf16_t* W3 = (bf16_t*)(ws + WS_W3S);
    constexpr int E_K = 2 * 16 * 16 * 256, E_W1 = 2 * 16 * 64 * 256, E_W3 = 2 * 16 * 256 * 64;
    for (int e = blockIdx.x * 512 + tid; e < E_K + E_W1 + E_W3; e += G * 512) {
        int r = e;
        if (r < E_K) { const int q = r & 15, p = (r >> 4) & 15, d = (r >> 8) & 15, lg = r >> 12; float s = 0.f;
#pragma unroll 8
            for (int n = 0; n < 64; ++n) { const size_t lgn = (size_t)lg * 64 + n; const float cr = A.in[13][(lg * 16 + p) * 64 + n], ci = A.in[14][(lg * 16 + p) * 64 + n];
                const float lr = LAM[2 * (lgn * 17 + d)], li = LAM[2 * (lgn * 17 + d) + 1], br = BB[2 * (lgn * 16 + q)], bi = BB[2 * (lgn * 16 + q) + 1];
                const float tr = lr * br - li * bi, ti = lr * bi + li * br; s += cr * tr - ci * ti; }
            const bf16_t v = (bf16_t)f2bf(s); bf16_t* km = KM + (size_t)lg * 65536;
            for (int j = d; j < 16; ++j) { km[(j * 16 + p) * 256 + (j - d) * 16 + q] = v; if (d > 0) km[((j - d) * 16 + p) * 256 + j * 16 + q] = 0; }
            continue; } r -= E_K;
        if (r < E_W1) { const int q = r & 15, j = (r >> 4) & 15, n = (r >> 8) & 63, lg = r >> 14; const size_t lgn = (size_t)lg * 64 + n;
            const float lr = LAM[2 * (lgn * 17 + 15 - j)], li = LAM[2 * (lgn * 17 + 15 - j) + 1], br = BB[2 * (lgn * 16 + q)], bi = BB[2 * (lgn * 16 + q) + 1];
            bf16_t* w = W1 + (size_t)lg * 128 * 256; w[n * 256 + j * 16 + q] = (bf16_t)f2bf(lr * br - li * bi); w[(64 + n) * 256 + j * 16 + q] = (bf16_t)f2bf(lr * bi + li * br);
            continue; } r -= E_W1;
        { const int n = r & 63, p = (r >> 6) & 15, j = (r >> 10) & 15, lg = r >> 14; const size_t lgn = (size_t)lg * 64 + n;
            const float cr = A.in[13][(lg * 16 + p) * 64 + n], ci = A.in[14][(lg * 16 + p) * 64 + n], lr = LAM[2 * (lgn * 17 + j + 1)], li = LAM[2 * (lgn * 17 + j + 1) + 1];
            bf16_t* w = W3 + (size_t)lg * 256 * 128; w[(j * 16 + p) * 128 + n] = (bf16_t)f2bf(cr * lr - ci * li); w[(j * 16 + p) * 128 + 64 + n] = (bf16_t)f2bf(-(cr * li + ci * lr)); }
    }
}
__device__ __forceinline__ void bias_gemv(const Args& A, int lane, int wave) {
    unsigned char* ws = A.ws; const int gw = blockIdx.x * 8 + wave, NGW = gridDim.x * 8;
    for (int r = gw; r < 2 * 11520; r += NGW) {
        const int l = r / 11520; int rr = r % 11520; const bf16_t* wrow; const float* sh; float* out; int stride; float add;
        if (rr < 5888) { wrow = (const bf16_t*)(ws + WS_WIN) + ((size_t)l * NINP + rr) * 1024; sh = (const float*)(ws + WS_MODV) + (size_t)l * 8 * 6144; out = (float*)(ws + WS_BIASB_IN) + (size_t)l * 8 * 5888 + rr; stride = 5888; add = ((const float*)(ws + WS_BIASP))[l * NINP + rr]; }
        else { rr -= 5888; wrow = (const bf16_t*)(ws + WS_W13) + ((size_t)l * 5632 + rr) * 1024; sh = (const float*)(ws + WS_MODV) + (size_t)l * 8 * 6144 + 3072; out = (float*)(ws + WS_BIASB_F) + (size_t)l * 8 * 5632 + rr; stride = 5632; add = 0.f; }
        const u4 w0 = *(const u4*)(wrow + 16 * lane), w1 = *(const u4*)(wrow + 16 * lane + 8);
        const float w[16] = {blo(w0.x), bhi(w0.x), blo(w0.y), bhi(w0.y), blo(w0.z), bhi(w0.z), blo(w0.w), bhi(w0.w), blo(w1.x), bhi(w1.x), blo(w1.y), bhi(w1.y), blo(w1.z), bhi(w1.z), blo(w1.w), bhi(w1.w)};
#pragma unroll
        for (int b = 0; b < 8; ++b) { const f4* sp = (const f4*)(sh + (size_t)b * 6144 + 16 * lane); float s = 0.f;
#pragma unroll
            for (int q = 0; q < 4; ++q) { const f4 v = sp[q]; s += (w[4 * q] * v.x + w[4 * q + 1] * v.y) + (w[4 * q + 2] * v.z + w[4 * q + 3] * v.w); }
            s = wave_sum(s); if (lane == 0) out[(size_t)b * stride] = s + add; }
    }
}
__device__ __forceinline__ void norm_prep0(const float* x, const float* g, const float* mod, int sc_off, bf16_t* H, float* rowss, int lane, int wave) {
    const int gw = blockIdx.x * 8 + wave, NGW = gridDim.x * 8;
    for (int row = gw; row < NTOK; row += NGW) {
        const f4* xr = (const f4*)(x + (size_t)row * 1024) + lane; f4 v[4]; float ss = 0.f;
#pragma unroll
        for (int j = 0; j < 4; ++j) { v[j] = xr[64 * j]; ss += (v[j].x * v[j].x + v[j].y * v[j].y) + (v[j].z * v[j].z + v[j].w * v[j].w); }
        ss = wave_sum(ss); if (lane == 0) rowss[row] = ss;
        const float* mp = mod + (size_t)(row >> 13) * 6144;
#pragma unroll
        for (int j = 0; j < 4; ++j) { const int col = 4 * lane + 256 * j; const f4 gg = *(const f4*)(g + col), sc = *(const f4*)(mp + sc_off + col);
            const f4 y = v[j] * gg * (sc + 1.f); u2 o; o.x = pk2(y.x, y.y); o.y = pk2(y.z, y.w); *(u2*)(H + (size_t)row * 1024 + col) = o; }
    }
}
__device__ __forceinline__ void norm_mod(const float* x, const float* g, const float* mod, int sh_off, int sc_off, bf16_t* H, int lane, int wave) {
    const int gw = blockIdx.x * 8 + wave, NGW = gridDim.x * 8;
    for (int row = gw; row < NTOK; row += NGW) {
        const f4* xr = (const f4*)(x + (size_t)row * 1024) + lane; f4 v[4]; float ss = 0.f;
#pragma unroll
        for (int j = 0; j < 4; ++j) { v[j] = xr[64 * j]; ss += (v[j].x * v[j].x + v[j].y * v[j].y) + (v[j].z * v[j].z + v[j].w * v[j].w); }
        const float rstd = rsqrtf(wave_sum(ss) * (1.f / 1024.f) + EPSN);
        const float* mp = mod + (size_t)(row >> 13) * 6144;
#pragma unroll
        for (int j = 0; j < 4; ++j) { const int col = 4 * lane + 256 * j; const f4 gg = *(const f4*)(g + col), sc = *(const f4*)(mp + sc_off + col), sh = *(const f4*)(mp + sh_off + col);
            const f4 y = v[j] * rstd * gg * (sc + 1.f) + sh; u2 o; o.x = pk2(y.x, y.y); o.y = pk2(y.z, y.w); *(u2*)(H + (size_t)row * 1024 + col) = o; }
    }
}
__device__ __forceinline__ void norm_final(float* x, const float* g, int lane, int wave) {
    const int gw = blockIdx.x * 8 + wave, NGW = gridDim.x * 8;
    for (int row = gw; row < NTOK; row += NGW) {
        f4* xr = (f4*)(x + (size_t)row * 1024) + lane; f4 v[4]; float ss = 0.f;
#pragma unroll
        for (int j = 0; j < 4; ++j) { v[j] = xr[64 * j]; ss += (v[j].x * v[j].x + v[j].y * v[j].y) + (v[j].z * v[j].z + v[j].w * v[j].w); }
        const float rstd = rsqrtf(wave_sum(ss) * (1.f / 1024.f) + EPSN);
#pragma unroll
        for (int j = 0; j < 4; ++j) { const f4 gg = *(const f4*)(g + 4 * lane + 256 * j); xr[64 * j] = v[j] * rstd * gg; }
    }
}
__device__ __forceinline__ void norm_final2(const bf16_t* XT, const float* rowss, float* out, int lane, int wave) {
    const int gw = blockIdx.x * 8 + wave, NGW = gridDim.x * 8;
    for (int row = gw; row < NTOK; row += NGW) {
        const float rstd = rsqrtf(rowss[row] * (1.f / 1024.f) + EPSN); const u2* xr = (const u2*)(XT + (size_t)row * 1024) + lane; f4* orow = (f4*)(out + (size_t)row * 1024) + lane;
        u2 w[4];
#pragma unroll
        for (int j = 0; j < 4; ++j) w[j] = xr[64 * j];
#pragma unroll
        for (int j = 0; j < 4; ++j) orow[64 * j] = (f4){blo(w[j].x) * rstd, bhi(w[j].x) * rstd, blo(w[j].y) * rstd, bhi(w[j].y) * rstd};
    }
}
__device__ __forceinline__ void scalars_phase(const Args& A, LAS unsigned char* lds, int tid, int lane, int wave) {
    unsigned char* ws = A.ws; const float* G32 = (const float*)(ws + WS_G32);
    LAS float* sm = (LAS float*)lds;
    for (int it = blockIdx.x; it < 80; it += gridDim.x) {
        if (it < 48) {
            const int b = it / 6, h = it % 6; const float* gp = G32 + ((size_t)b * SEQL + 16 * tid) * 16 + 8 + h; float v[16]; float run = 0.f;
#pragma unroll
            for (int i = 0; i < 16; ++i) { run += logsig(gp[i * 16]); v[i] = run; }
            float inc = run;
#pragma unroll
            for (int o = 1; o < 64; o <<= 1) { const float t = __shfl_up(inc, o); if (lane >= o) inc += t; }
            if (lane == 63) sm[wave] = inc;
            __syncthreads();
            float off = inc - run;
#pragma unroll
            for (int w = 0; w < 8; ++w) if (w < wave) off += sm[w];
            float* fb = (float*)(ws + WS_FB) + (size_t)it * SEQL + 16 * tid;
#pragma unroll
            for (int i = 0; i < 16; i += 4) *(f4*)(fb + i) = (f4){-(off + v[i]) * LOG2E, -(off + v[i + 1]) * LOG2E, -(off + v[i + 2]) * LOG2E, -(off + v[i + 3]) * LOG2E};
            __syncthreads();
        } else {
            const int bh = it - 48, b = bh >> 2, h = bh & 3; const float* gp = G32 + ((size_t)b * SEQL + 16 * tid) * 16; float bl[16], li[16]; float run = 0.f;
#pragma unroll
            for (int i = 0; i < 16; ++i) { li[i] = gp[i * 16 + h]; run += logsig(gp[i * 16 + 4 + h]); bl[i] = run; }
            float inc = run;
#pragma unroll
            for (int o = 1; o < 8; o <<= 1) { const float t = __shfl_up(inc, o); if ((lane & 7) >= o) inc += t; }
            const float off = inc - run; float amax = -INFINITY;
            float* ab = (float*)(ws + WS_ABUF) + (size_t)bh * SEQL + 16 * tid; float* bb = (float*)(ws + WS_BBUF) + (size_t)bh * SEQL + 16 * tid;
#pragma unroll
            for (int i = 0; i < 16; ++i) { bl[i] += off; li[i] -= bl[i]; amax = fmaxf(amax, li[i]); }
#pragma unroll
            for (int i = 0; i < 16; i += 4) { *(f4*)(ab + i) = (f4){li[i], li[i + 1], li[i + 2], li[i + 3]}; *(f4*)(bb + i) = (f4){bl[i], bl[i + 1], bl[i + 2], bl[i + 3]}; }
            amax = fmaxf(amax, __shfl_xor(amax, 1)); amax = fmaxf(amax, __shfl_xor(amax, 2)); amax = fmaxf(amax, __shfl_xor(amax, 4));
            if ((lane & 7) == 7) { sm[tid >> 3] = amax; sm[64 + (tid >> 3)] = bl[15]; }
            __syncthreads();
            if (tid == 0) { float m = 0.f; float* ms = (float*)(ws + WS_MS) + bh * 64; float* ax = (float*)(ws + WS_AMX) + bh * 64;
                for (int c = 0; c < 64; ++c) { ms[c] = m; ax[c] = sm[c]; m = sm[64 + c] + fmaxf(m, sm[c]); } }
            __syncthreads();
        }
    }
}
__device__ __forceinline__ void qk_norms(const Args& A, int l, LAS unsigned char* lds, int tid) {
    unsigned char* ws = A.ws; const bf16_t* Z = (const bf16_t*)(ws + WS_Z); unsigned* NRM = (unsigned*)(ws + WS_NRM) + l * 96;
    LAS unsigned* sm = (LAS unsigned*)lds;
    for (int it = blockIdx.x; it < 2048; it += gridDim.x) {
        if (tid < 12) sm[tid] = 0u;
        LDS_BARRIER();
        if (tid < 384) { const int t = tid / 12, j = tid % 12; const size_t tok = (size_t)it * 32 + t; const int col = (j < 6) ? ZC_FQ + j * 64 : ZC_FK + (j - 6) * 64;
            const u4* p = (const u4*)(Z + tok * ZP + col); float ss = 0.f;
#pragma unroll
            for (int q = 0; q < 8; ++q) { const u4 w = p[q]; const float a0 = blo(w.x), a1 = bhi(w.x), a2 = blo(w.y), a3 = bhi(w.y), a4 = blo(w.z), a5 = bhi(w.z), a6 = blo(w.w), a7 = bhi(w.w);
                ss += (a0 * a0 + a1 * a1) + (a2 * a2 + a3 * a3) + (a4 * a4 + a5 * a5) + (a6 * a6 + a7 * a7); }
            __hip_atomic_fetch_max(sm + j, __float_as_uint(ss), __ATOMIC_RELAXED, __HIP_MEMORY_SCOPE_WORKGROUP); }
        LDS_BARRIER();
        if (tid < 12) { const int b = (it * 32) >> 13, h = tid % 6, qk = tid / 6; __hip_atomic_fetch_max(NRM + (b * 6 + h) * 2 + qk, sm[tid], __ATOMIC_RELAXED, __HIP_MEMORY_SCOPE_AGENT); }
        LDS_BARRIER();
    }
}
__device__ __forceinline__ void s5_stage_u(const bf16_t* Z, LAS bf16_t* UL, int g, int cb, int tid) {
    u4 r[8];
#pragma unroll
    for (int q = 0; q < 8; ++q) { const int v = tid + 512 * q, c = v >> 5, j = (v >> 1) & 15, half = v & 1; const int ch = cb * 128 + c, b = ch >> 9, chunk = ch & 511;
        r[q] = *(const u4*)(Z + ((size_t)b * SEQL + chunk * 16 + j) * ZP + ZC_S5 + g * 16 + 8 * half); }
#pragma unroll
    for (int q = 0; q < 8; ++q) { const int v = tid + 512 * q, c = v >> 5, j = (v >> 1) & 15, half = v & 1; *(LAS u4*)(UL + c * 264 + j * 16 + 8 * half) = r[q]; }
}
__device__ __forceinline__ void s5_pass1(const Args& A, int l, LAS unsigned char* lds, int tid, int lane, int wave) {
    unsigned char* ws = A.ws; const bf16_t* Z = (const bf16_t*)(ws + WS_Z); float* ES = (float*)(ws + WS_ES);
    LAS bf16_t* UL = (LAS bf16_t*)lds; const int kb = lane >> 4, ln = lane & 15;
    for (int u = blockIdx.x; u < 512; u += gridDim.x) {
        const int g = u >> 5, cb = u & 31;
        s5_stage_u(Z, UL, g, cb, tid);
        const bf16_t* w1 = (const bf16_t*)(ws + WS_W1S) + ((size_t)(l * 16 + g) * 128 + 16 * wave + ln) * 256 + 8 * kb;
        h8 af[8];
#pragma unroll
        for (int ks = 0; ks < 8; ++ks) af[ks] = *(const h8*)(w1 + 32 * ks);
        LDS_BARRIER();
#pragma unroll 2
        for (int ct = 0; ct < 8; ++ct) { f4 acc = (f4){0.f, 0.f, 0.f, 0.f}; const LAS bf16_t* up = UL + (ct * 16 + ln) * 264 + (kb >> 1) * 16 + 8 * (kb & 1);
#pragma unroll
            for (int ks = 0; ks < 8; ++ks) { const h8 bf = *(const LAS h8*)(up + 32 * ks); acc = MFMA16(af[ks], bf, acc); }
            const int ch = cb * 128 + ct * 16 + ln, b = ch >> 9, chunk = ch & 511;
            *(f4*)(ES + ((size_t)(b * 16 + g) * 512 + chunk) * 128 + 16 * wave + 4 * kb) = acc; }
        LDS_BARRIER();
    }
}
__device__ __forceinline__ void s5_pass2(const Args& A, int l, LAS unsigned char* lds, int tid, int lane, int wave) {
    unsigned char* ws = A.ws; const float* ES = (const float*)(ws + WS_ES); bf16_t* XS = (bf16_t*)(ws + WS_XS); const float* LAM = (const float*)(ws + WS_LAM);
    LAS float* er_s = (LAS float*)lds; LAS float* ei_s = er_s + 512;
    for (int bg = blockIdx.x; bg < 128; bg += gridDim.x) {
        const int g = bg & 15; const size_t lgn = (size_t)(l * 16 + g) * 64 + lane;
        const float lr = LAM[2 * (lgn * 17 + 16)], li = LAM[2 * (lgn * 17 + 16) + 1]; float cr = 0.f, ci = 0.f;
        const float* e = ES + ((size_t)bg * 512 + wave * 64) * 128 + lane; bf16_t* xo = XS + ((size_t)bg * 512 + wave * 64) * 128 + lane;
        for (int c0 = 0; c0 < 64; c0 += 16) { float er[16], ei[16];
#pragma unroll
            for (int k = 0; k < 16; ++k) { er[k] = e[(size_t)(c0 + k) * 128]; ei[k] = e[(size_t)(c0 + k) * 128 + 64]; }
#pragma unroll
            for (int k = 0; k < 16; ++k) { const float nr = lr * cr - li * ci + er[k], ni = lr * ci + li * cr + ei[k]; cr = nr; ci = ni; } }
        er_s[wave * 64 + lane] = cr; ei_s[wave * 64 + lane] = ci;
        __syncthreads();
        float pr = lr, pi = li;
#pragma unroll
        for (int q = 0; q < 6; ++q) { const float t = pr * pr - pi * pi; pi = 2.f * pr * pi; pr = t; }
        cr = 0.f; ci = 0.f;
        for (int s = 0; s < wave; ++s) { const float nr = pr * cr - pi * ci + er_s[s * 64 + lane], ni = pr * ci + pi * cr + ei_s[s * 64 + lane]; cr = nr; ci = ni; }
        for (int c0 = 0; c0 < 64; c0 += 16) { float er[16], ei[16];
#pragma unroll
            for (int k = 0; k < 16; ++k) { er[k] = e[(size_t)(c0 + k) * 128]; ei[k] = e[(size_t)(c0 + k) * 128 + 64]; }
#pragma unroll
            for (int k = 0; k < 16; ++k) { xo[(size_t)(c0 + k) * 128] = (bf16_t)f2bf(cr); xo[(size_t)(c0 + k) * 128 + 64] = (bf16_t)f2bf(ci);
                const float nr = lr * cr - li * ci + er[k], ni = lr * ci + li * cr + ei[k]; cr = nr; ci = ni; } }
        __syncthreads();
    }
}
__device__ __forceinline__ void s5_pass3(const Args& A, int l, LAS unsigned char* lds, int tid, int lane, int wave) {
    unsigned char* ws = A.ws; const bf16_t* Z = (const bf16_t*)(ws + WS_Z); const bf16_t* XS = (const bf16_t*)(ws + WS_XS); bf16_t* YG = (bf16_t*)(ws + WS_C);
    LAS bf16_t* UL = (LAS bf16_t*)lds; LAS bf16_t* XL = (LAS bf16_t*)(lds + 67584); const int kb = lane >> 4, ln = lane & 15;
    for (int u = blockIdx.x; u < 512; u += gridDim.x) {
        const int g = u >> 5, cb = u & 31;
        s5_stage_u(Z, UL, g, cb, tid);
        { u4 r[4];
#pragma unroll
          for (int q = 0; q < 4; ++q) { const int v = tid + 512 * q, c = v >> 4, pc = v & 15; const int ch = cb * 128 + c, b = ch >> 9, chunk = ch & 511; r[q] = *(const u4*)(XS + ((size_t)(b * 16 + g) * 512 + chunk) * 128 + 8 * pc); }
#pragma unroll
          for (int q = 0; q < 4; ++q) { const int v = tid + 512 * q, c = v >> 4, pc = v & 15; *(LAS u4*)(XL + c * 136 + 8 * pc) = r[q]; } }
        h8 ka0[4], ka1[8], wa[2][4];
#pragma unroll
        for (int jj = 0; jj < 2; ++jj) { const int jr = jj ? 15 - wave : wave;
            const bf16_t* km = (const bf16_t*)(ws + WS_KMAT) + ((size_t)(l * 16 + g) * 256 + jr * 16 + ln) * 256 + 8 * kb;
            const bf16_t* w3 = (const bf16_t*)(ws + WS_W3S) + ((size_t)(l * 16 + g) * 256 + jr * 16 + ln) * 128 + 8 * kb;
            if (jj == 0) {
#pragma unroll
                for (int ks = 0; ks < 4; ++ks) ka0[ks] = *(const h8*)(km + 32 * ks); }
            else {
#pragma unroll
                for (int ks = 0; ks < 8; ++ks) ka1[ks] = *(const h8*)(km + 32 * ks); }
#pragma unroll
            for (int ks = 0; ks < 4; ++ks) wa[jj][ks] = *(const h8*)(w3 + 32 * ks); }
        const f4 dv = *(const f4*)(A.in[15] + (size_t)l * 256 + g * 16 + 4 * kb);
        LDS_BARRIER();
#pragma unroll 2
        for (int ct = 0; ct < 8; ++ct) {
            const int ch = cb * 128 + ct * 16 + ln, b = ch >> 9, chunk = ch & 511; const size_t tok0 = (size_t)b * SEQL + chunk * 16;
            const LAS bf16_t* ul = UL + (ct * 16 + ln) * 264; const LAS bf16_t* up = ul + (kb >> 1) * 16 + 8 * (kb & 1); const LAS bf16_t* xp = XL + (ct * 16 + ln) * 136 + 8 * kb;
            h8 ub[8], xb[4];
#pragma unroll
            for (int ks = 0; ks < 8; ++ks) ub[ks] = *(const LAS h8*)(up + 32 * ks);
#pragma unroll
            for (int ks = 0; ks < 4; ++ks) xb[ks] = *(const LAS h8*)(xp + 32 * ks);
#pragma unroll
            for (int jj = 0; jj < 2; ++jj) { const int jr = jj ? 15 - wave : wave; f4 acc = (f4){0.f, 0.f, 0.f, 0.f};
                if (jj == 0) {
#pragma unroll
                    for (int ks = 0; ks < 4; ++ks) if (2 * ks <= jr) acc = MFMA16(ka0[ks], ub[ks], acc); }
                else {
#pragma unroll
                    for (int ks = 0; ks < 8; ++ks) if (2 * ks <= jr) acc = MFMA16(ka1[ks], ub[ks], acc); }
#pragma unroll
                for (int ks = 0; ks < 4; ++ks) acc = MFMA16(wa[jj][ks], xb[ks], acc);
                const u2 uw = *(const LAS u2*)(ul + jr * 16 + 4 * kb); const f4 uu = (f4){blo(uw.x), bhi(uw.x), blo(uw.y), bhi(uw.y)};
                f4 y = acc + dv * uu;
#pragma unroll
                for (int i = 0; i < 4; ++i) { const float t = y[i]; y[i] = t * sigmf(1.5957691216057308f * (t + 0.044715f * t * t * t)); }
                u2 o; o.x = pk2(y[0], y[1]); o.y = pk2(y[2], y[3]); *(u2*)(YG + (tok0 + jr) * CPITCH + 768 + g * 16 + 4 * kb) = o; }
        }
        LDS_BARRIER();
    }
}
__device__ __forceinline__ void mlstm_qk(const Args& A, int l, LAS unsigned char* lds, int tid, int lane, int wave) {
    unsigned char* ws = A.ws; const bf16_t* Z = (const bf16_t*)(ws + WS_Z); bf16_t* QK = (bf16_t*)(ws + WS_C);
    LAS bf16_t* cx = (LAS bf16_t*)lds; const int kb = lane >> 4, ln = lane & 15; const int G = gridDim.x;
    const float* cw = A.in[17] + (size_t)l * 4 * 384; const float* cbv = A.in[18] + (size_t)l * 384;
    u4 xw[3][4];
#define MQK_LOAD(u_) do { const int tile_ = (u_) >> 2, h_ = (u_) & 3; _Pragma("unroll") for (int vi = 0; vi < 3; ++vi) { const int v = tid + 512 * vi, t = v / 12, dg = v % 12, c = h_ * 96 + 8 * dg; const int tok = tile_ * 128 + t, pos = tok & (SEQL - 1); \
        _Pragma("unroll") for (int tap = 0; tap < 4; ++tap) { xw[vi][tap] = (u4){0u, 0u, 0u, 0u}; if (pos - 3 + tap >= 0) xw[vi][tap] = *(const u4*)(Z + (size_t)(tok - 3 + tap) * ZP + ZC_MQK + c); } } } while (0)
    LAS bf16_t* WL = (LAS bf16_t*)(lds + 26624); int hcur = -1;
    int u = blockIdx.x; if (u < 2048) MQK_LOAD(u);
    for (; u < 2048; u += G) {
        const int tile = u >> 2, h = u & 3;
        if (h != hcur) { hcur = h; const bf16_t* wsrc = (const bf16_t*)(ws + WS_WQK) + (size_t)(l * 4 + h) * 192 * 96;
            for (int v = tid; v < 192 * 12; v += 512) { const int r = v / 12, dg = v % 12; *(LAS u4*)(WL + r * 104 + 8 * dg) = *(const u4*)(wsrc + r * 96 + 8 * dg); } }
#pragma unroll
        for (int vi = 0; vi < 3; ++vi) { const int v = tid + 512 * vi; const int t = v / 12, dg = v % 12, c = h * 96 + 8 * dg;
            float acc[8];
#pragma unroll
            for (int e = 0; e < 8; ++e) acc[e] = cbv[c + e];
#pragma unroll
            for (int tap = 0; tap < 4; ++tap) { const u4 x4 = xw[vi][tap]; const float* w = cw + tap * 384 + c;
                acc[0] += w[0] * blo(x4.x); acc[1] += w[1] * bhi(x4.x); acc[2] += w[2] * blo(x4.y); acc[3] += w[3] * bhi(x4.y);
                acc[4] += w[4] * blo(x4.z); acc[5] += w[5] * bhi(x4.z); acc[6] += w[6] * blo(x4.w); acc[7] += w[7] * bhi(x4.w); }
#pragma unroll
            for (int e = 0; e < 8; ++e) acc[e] = acc[e] * sigmf(acc[e]);
            u4 o; o.x = pk2(acc[0], acc[1]); o.y = pk2(acc[2], acc[3]); o.z = pk2(acc[4], acc[5]); o.w = pk2(acc[6], acc[7]);
            *(LAS u4*)(cx + t * 104 + 8 * dg) = o; }
        LDS_BARRIER();
        if (u + G < 2048) MQK_LOAD(u + G);
        h8 bfr[3];
#pragma unroll
        for (int ks = 0; ks < 3; ++ks) bfr[ks] = *(const LAS h8*)(cx + (16 * wave + ln) * 104 + 32 * ks + 8 * kb);
        const LAS bf16_t* wq = WL + ln * 104 + 8 * kb;
        const size_t tok = (size_t)tile * 128 + 16 * wave + ln;
#pragma unroll 4
        for (int et = 0; et < 12; ++et) { f4 acc = (f4){0.f, 0.f, 0.f, 0.f};
#pragma unroll
            for (int ks = 0; ks < 3; ++ks) { const h8 af = *(const LAS h8*)(wq + et * 16 * 104 + 32 * ks); acc = MFMA16(af, bfr[ks], acc); }
            const int col = (et < 6) ? (h * 96 + et * 16 + 4 * kb) : (384 + h * 96 + (et - 6) * 16 + 4 * kb);
            u2 o; o.x = pk2(acc[0], acc[1]); o.y = pk2(acc[2], acc[3]); *(u2*)(QK + tok * CPITCH + col) = o; }
        LDS_BARRIER();
    }
#undef MQK_LOAD
}
__device__ __forceinline__ void mlstm_localkv(const Args& A, LAS unsigned char* lds, int tid, int lane, int wave) {
    unsigned char* ws = A.ws; const bf16_t* Z = (const bf16_t*)(ws + WS_Z); const bf16_t* QK = (const bf16_t*)(ws + WS_C); bf16_t* ST = (bf16_t*)(ws + WS_ST);
    LAS bf16_t* KT = (LAS bf16_t*)lds; LAS bf16_t* VT = (LAS bf16_t*)(lds + 26112); const int kb = lane >> 4, ln = lane & 15; const int G = gridDim.x;
    u4 kwr[3], vwr[3]; float wl[3];
#define LKV_LOAD(u_) do { const int bh_ = (u_) >> 6, c_ = (u_) & 63, b_ = bh_ >> 2, h_ = bh_ & 3; const size_t tok0_ = (size_t)b_ * SEQL + c_ * 128; \
        const float amx_ = ((const float*)(ws + WS_AMX))[u_]; const float* ab_ = (const float*)(ws + WS_ABUF) + (size_t)bh_ * SEQL + c_ * 128; \
        _Pragma("unroll") for (int vi = 0; vi < 3; ++vi) { const int v = tid + 512 * vi, s = v / 12, dg = v % 12; wl[vi] = ab_[s] - amx_; \
            kwr[vi] = *(const u4*)(QK + (tok0_ + s) * CPITCH + 384 + h_ * 96 + 8 * dg); vwr[vi] = *(const u4*)(Z + (tok0_ + s) * ZP + ZC_MV + h_ * 96 + 8 * dg); } } while (0)
    int u = blockIdx.x; if (u < 2048) LKV_LOAD(u);
    for (; u < 2048; u += G) {
#pragma unroll
        for (int vi = 0; vi < 3; ++vi) { const int v = tid + 512 * vi; const int s = v / 12, dg = v % 12; const float w = __expf(wl[vi]); const u4 kw = kwr[vi], vw = vwr[vi];
            const int sz = s ^ ((dg & 7) << 3);
            LAS bf16_t* kt = KT + (8 * dg) * 136 + sz; LAS bf16_t* vt = VT + (8 * dg) * 136 + sz;
            kt[0] = (bf16_t)(kw.x & 0xffff); kt[136] = (bf16_t)(kw.x >> 16); kt[272] = (bf16_t)(kw.y & 0xffff); kt[408] = (bf16_t)(kw.y >> 16);
            kt[544] = (bf16_t)(kw.z & 0xffff); kt[680] = (bf16_t)(kw.z >> 16); kt[816] = (bf16_t)(kw.w & 0xffff); kt[952] = (bf16_t)(kw.w >> 16);
            vt[0] = (bf16_t)f2bf(w * blo(vw.x)); vt[136] = (bf16_t)f2bf(w * bhi(vw.x)); vt[272] = (bf16_t)f2bf(w * blo(vw.y)); vt[408] = (bf16_t)f2bf(w * bhi(vw.y));
            vt[544] = (bf16_t)f2bf(w * blo(vw.z)); vt[680] = (bf16_t)f2bf(w * bhi(vw.z)); vt[816] = (bf16_t)f2bf(w * blo(vw.w)); vt[952] = (bf16_t)f2bf(w * bhi(vw.w));
            if (dg == 0) VT[96 * 136 + (s ^ 32)] = (bf16_t)f2bf(w); }
        for (int i = tid; i < 15 * 136; i += 512) VT[97 * 136 + i] = 0;
        LDS_BARRIER();
        if (u + G < 2048) LKV_LOAD(u + G);
        if (wave < 6) {
            h8 af[4];
#pragma unroll
            for (int ks = 0; ks < 4; ++ks) af[ks] = *(const LAS h8*)(KT + (16 * wave + ln) * 136 + ((32 * ks + 8 * kb) ^ ((((16 * wave + ln) >> 3) & 7) << 3)));
#pragma unroll
            for (int ct = 0; ct < 7; ++ct) { f4 acc = (f4){0.f, 0.f, 0.f, 0.f};
#pragma unroll
                for (int ks = 0; ks < 4; ++ks) { const h8 bf = *(const LAS h8*)(VT + (16 * ct + ln) * 136 + ((32 * ks + 8 * kb) ^ ((((16 * ct + ln) >> 3) & 7) << 3))); acc = MFMA16(af[ks], bf, acc); }
                const int v = 16 * ct + ln;
                if (v < 97) { u2 o; o.x = pk2(acc[0], acc[1]); o.y = pk2(acc[2], acc[3]); *(u2*)(ST + ((size_t)u * 97 + v) * 96 + 16 * wave + 4 * kb) = o; } }
        }
        LDS_BARRIER();
    }
#undef LKV_LOAD
}
__device__ __forceinline__ void mlstm_scan(const Args& A, int tid) {
    unsigned char* ws = A.ws; bf16_t* ST = (bf16_t*)(ws + WS_ST); const float* MS = (const float*)(ws + WS_MS); const float* AMX = (const float*)(ws + WS_AMX);
    for (int idx = blockIdx.x * 512 + tid; idx < 32 * 2328; idx += gridDim.x * 512) {
        const int bh = idx / 2328, e = idx % 2328; bf16_t* p = ST + (size_t)bh * 64 * 9312 + 4 * e; float c0 = 0.f, c1 = 0.f, c2 = 0.f, c3 = 0.f;
        u2 L[8], Ln[8]; float dl[8], db[8], dln[8], dbn[8];
#define MSC_LOAD(LL, DA, DB, cb_) do { _Pragma("unroll") for (int k = 0; k < 8; ++k) { LL[k] = *(const u2*)(p + (size_t)((cb_) + k) * 9312); const float ms = MS[bh * 64 + (cb_) + k], ax = AMX[bh * 64 + (cb_) + k], mx = fmaxf(ms, ax); DA[k] = ms - mx; DB[k] = ax - mx; } } while (0)
        MSC_LOAD(L, dl, db, 0);
        for (int cb = 0; cb < 64; cb += 8) {
            if (cb + 8 < 64) MSC_LOAD(Ln, dln, dbn, cb + 8);
#pragma unroll
            for (int k = 0; k < 8; ++k) { u2 o; o.x = pk2(c0, c1); o.y = pk2(c2, c3); *(u2*)(p + (size_t)(cb + k) * 9312) = o; const float al = __expf(dl[k]), be = __expf(db[k]);
                c0 = al * c0 + be * blo(L[k].x); c1 = al * c1 + be * bhi(L[k].x); c2 = al * c2 + be * blo(L[k].y); c3 = al * c3 + be * bhi(L[k].y); }
#pragma unroll
            for (int k = 0; k < 8; ++k) { L[k] = Ln[k]; dl[k] = dln[k]; db[k] = dbn[k]; }
        }
#undef MSC_LOAD
    }
}
__device__ __forceinline__ void mlstm_out(const Args& A, int l, LAS unsigned char* lds, int tid, int lane, int wave, int ocol) {
    unsigned char* ws = A.ws; bf16_t* Z = (bf16_t*)(ws + WS_Z); const bf16_t* QK = (const bf16_t*)(ws + WS_C); const bf16_t* ST = (const bf16_t*)(ws + WS_ST);
    LAS bf16_t* Qs = (LAS bf16_t*)lds; LAS bf16_t* Ks = (LAS bf16_t*)(lds + 26624); LAS bf16_t* VT = (LAS bf16_t*)(lds + 53248); LAS bf16_t* CS = (LAS bf16_t*)(lds + 79360);
    LAS bf16_t* Ps = (LAS bf16_t*)(lds + 102656); LAS float* aL = (LAS float*)(lds + 137472); LAS float* MxL = aL + 128; LAS float* bL = aL + 256;
    const int kb = lane >> 4, ln = lane & 15; const float* ng = A.in[21] + (size_t)l * 384;
    const int G = gridDim.x; u4 qr_[3], kr_[3], vr_[3], cr_[3];
#define MO_LOAD(u_) do { const int bh_ = (u_) >> 6, c_ = (u_) & 63, b_ = bh_ >> 2, h_ = bh_ & 3; const size_t tok0_ = (size_t)b_ * SEQL + c_ * 128; \
        _Pragma("unroll") for (int vi = 0; vi < 3; ++vi) { const int v = tid + 512 * vi, s = v / 12, dg = v % 12; \
            qr_[vi] = *(const u4*)(QK + (tok0_ + s) * CPITCH + h_ * 96 + 8 * dg); kr_[vi] = *(const u4*)(QK + (tok0_ + s) * CPITCH + 384 + h_ * 96 + 8 * dg); \
            vr_[vi] = *(const u4*)(Z + (tok0_ + s) * ZP + ZC_MV + h_ * 96 + 8 * dg); \
            cr_[vi] = (u4){0u, 0u, 0u, 0u}; if (v < 97 * 12) cr_[vi] = *(const u4*)(ST + ((size_t)(u_) * 97 + s) * 96 + 8 * dg); } } while (0)
    int u = blockIdx.x; if (u < 2048) MO_LOAD(u);
    for (; u < 2048; u += G) {
        const int bh = u >> 6, c = u & 63, b = bh >> 2, h = bh & 3; const size_t tok0 = (size_t)b * SEQL + c * 128;
        const float ms = ((const float*)(ws + WS_MS))[u];
#pragma unroll
        for (int vi = 0; vi < 3; ++vi) { const int v = tid + 512 * vi; const int s = v / 12, dg = v % 12;
            *(LAS u4*)(Qs + s * 104 + 8 * dg) = qr_[vi]; *(LAS u4*)(Ks + s * 104 + 8 * dg) = kr_[vi];
            const u4 vw = vr_[vi]; LAS bf16_t* vt = VT + (8 * dg) * 136 + (s ^ ((dg & 7) << 3));
            vt[0] = (bf16_t)(vw.x & 0xffff); vt[136] = (bf16_t)(vw.x >> 16); vt[272] = (bf16_t)(vw.y & 0xffff); vt[408] = (bf16_t)(vw.y >> 16);
            vt[544] = (bf16_t)(vw.z & 0xffff); vt[680] = (bf16_t)(vw.z >> 16); vt[816] = (bf16_t)(vw.w & 0xffff); vt[952] = (bf16_t)(vw.w >> 16);
            if (v < 112 * 12) *(LAS u4*)(CS + s * 104 + 8 * dg) = cr_[vi]; }
        if (wave == 0) { const float* ab = (const float*)(ws + WS_ABUF) + (size_t)bh * SEQL + c * 128; const float* bb = (const float*)(ws + WS_BBUF) + (size_t)bh * SEQL + c * 128;
            const float a0 = ab[2 * lane], a1 = ab[2 * lane + 1]; float inc = fmaxf(a0, a1);
#pragma unroll
            for (int o = 1; o < 64; o <<= 1) { const float t = __shfl_up(inc, o); if (lane >= o) inc = fmaxf(inc, t); }
            float prev = __shfl_up(inc, 1); if (lane == 0) prev = -INFINITY;
            aL[2 * lane] = a0; aL[2 * lane + 1] = a1; MxL[2 * lane] = fmaxf(ms, fmaxf(prev, a0)); MxL[2 * lane + 1] = fmaxf(ms, inc);
            bL[2 * lane] = bb[2 * lane]; bL[2 * lane + 1] = bb[2 * lane + 1]; }
        LDS_BARRIER();
        if (u + G < 2048) MO_LOAD(u + G);
        {
            const int tt = 16 * wave + ln; const float mxt = MxL[tt], inter = __expf(ms - mxt);
            bf16_t* op = Z + (tok0 + tt) * ZP + ZC_MO + h * 96 + 4 * kb; u2 owv[6]; f4 g4v[6];
#pragma unroll
            for (int rt = 0; rt < 6; ++rt) { owv[rt] = *(const u2*)(op + 16 * rt); g4v[rt] = *(const f4*)(ng + h * 96 + 16 * rt + 4 * kb); }
            h8 qf[3];
#pragma unroll
            for (int ks = 0; ks < 3; ++ks) qf[ks] = *(const LAS h8*)(Qs + tt * 104 + 32 * ks + 8 * kb);
            f4 an[7];
#pragma unroll
            for (int rt = 0; rt < 7; ++rt) { f4 acc = (f4){0.f, 0.f, 0.f, 0.f};
#pragma unroll
                for (int ks = 0; ks < 3; ++ks) { const h8 af = *(const LAS h8*)(CS + (16 * rt + ln) * 104 + 32 * ks + 8 * kb); acc = MFMA16(af, qf[ks], acc); }
                an[rt] = acc * inter; }
            float rsum = 0.f;
            for (int st = 0; st <= wave; ++st) { f4 acc = (f4){0.f, 0.f, 0.f, 0.f};
#pragma unroll
                for (int ks = 0; ks < 3; ++ks) { const h8 af = *(const LAS h8*)(Ks + (16 * st + ln) * 104 + 32 * ks + 8 * kb); acc = MFMA16(af, qf[ks], acc); }
                const int s0 = 16 * st + 4 * kb; const f4 av = *(const LAS f4*)(aL + s0);
#pragma unroll
                for (int i = 0; i < 4; ++i) { const float w = (s0 + i <= tt) ? __expf(av[i] - mxt) : 0.f; acc[i] *= w; rsum += acc[i]; }
                u2 o; o.x = pk2(acc[0], acc[1]); o.y = pk2(acc[2], acc[3]); *(LAS u2*)(Ps + tt * 136 + s0) = o; }
            if ((wave & 1) == 0) { unsigned zz = 0u; asm volatile("" : "+v"(zz)); *(LAS u2*)(Ps + tt * 136 + 16 * (wave + 1) + 4 * kb) = (u2){zz, zz}; }
            asm volatile("s_waitcnt lgkmcnt(0)" ::: "memory");
            const int nks = (wave >> 1) + 1;
            for (int ks = 0; ks < nks; ++ks) { const h8 pf = *(const LAS h8*)(Ps + tt * 136 + 32 * ks + 8 * kb);
#pragma unroll
                for (int rt = 0; rt < 6; ++rt) { const h8 af = *(const LAS h8*)(VT + (16 * rt + ln) * 136 + ((32 * ks + 8 * kb) ^ ((((16 * rt + ln) >> 3) & 7) << 3))); an[rt] = MFMA16(af, pf, an[rt]); } }
            rsum += __shfl_xor(rsum, 16); rsum += __shfl_xor(rsum, 32);
            const float nq = __shfl(an[6][0], ln);
            const float den = rsum + nq, mt = bL[tt] + mxt, dd = __builtin_amdgcn_rcpf(fmaxf(fabsf(den), __expf(-mt)));
            float ss = 0.f;
#pragma unroll
            for (int rt = 0; rt < 6; ++rt) { an[rt] = an[rt] * dd; ss += (an[rt][0] * an[rt][0] + an[rt][1] * an[rt][1]) + (an[rt][2] * an[rt][2] + an[rt][3] * an[rt][3]); }
            ss += __shfl_xor(ss, 16); ss += __shfl_xor(ss, 32);
            const float rstd = rsqrtf(ss * (1.f / 96.f) + EPSN);
#pragma unroll
            for (int rt = 0; rt < 6; ++rt) { const u2 ow = owv[rt]; const f4 g4 = g4v[rt];
                const f4 y = an[rt] * rstd * g4; u2 o; o.x = pk2(y[0] * sigmf(blo(ow.x)), y[1] * sigmf(bhi(ow.x))); o.y = pk2(y[2] * sigmf(blo(ow.y)), y[3] * sigmf(bhi(ow.y)));
                *(u2*)(op + 16 * rt + ocol) = o; }
        }
        LDS_BARRIER();
    }
}
#define XB_TMO      128
#define XB_XCNT(j)  (256  + 64 * (j))
#define XB_XSUB(j)  (1280 + 64 * (j))
#define XB_XGEN(j)  (2304 + 64 * (j))
#define XB_TOP      3328
#define XB_TOPGEN   3392
#define XCD_BAR_WORDS 3456
#define XB_SPIN_CAP (1u << 18)

__device__ __forceinline__ unsigned xb_ld(unsigned* p)              { return __hip_atomic_load(p, __ATOMIC_RELAXED, __HIP_MEMORY_SCOPE_AGENT); }
__device__ __forceinline__ unsigned xb_add(unsigned* p, unsigned v) { return __hip_atomic_fetch_add(p, v, __ATOMIC_RELAXED, __HIP_MEMORY_SCOPE_AGENT); }
__device__ __forceinline__ unsigned xb_xcc_id() { return (unsigned)__builtin_amdgcn_s_getreg((3 << 11) | 20) & 0xFu; }
#define XB_SPIN(cond, bar) do { unsigned _sp = 0; while (cond) { __builtin_amdgcn_s_sleep(1); \
    if ((++_sp & 255u) == 0u) { if (xb_ld(&(bar)[XB_TMO])) break; if (_sp > XB_SPIN_CAP) { atomicAdd(&(bar)[XB_TMO], 1u); break; } } } } while (0)

struct XcdBarrier {
    unsigned* bar; unsigned x;
    volatile LAS unsigned* st;
};

__device__ __forceinline__ XcdBarrier xcd_barrier_post(unsigned* bar, volatile LAS unsigned* st) {
    XcdBarrier b; b.bar = bar; b.x = xb_xcc_id(); b.st = st;
    if (threadIdx.x == 0) (void)xb_add(&bar[XB_XCNT(b.x)], 1u);
    return b;
}
__device__ __forceinline__ void xcd_barrier_complete(unsigned* bar, unsigned x, unsigned& nloc, unsigned& nx) {
    const unsigned G = gridDim.x * gridDim.y * gridDim.z;
    unsigned sum, cnt, mine, sp = 0u;
    for (;;) {
        sum = 0u; cnt = 0u; mine = 0u;
#pragma unroll
        for (unsigned j = 0; j < 16; ++j) { const unsigned c = xb_ld(&bar[XB_XCNT(j)]); sum += c; cnt += (c > 0u) ? 1u : 0u; mine = (j == x) ? c : mine; }
        if (sum == G) break;
        __builtin_amdgcn_s_sleep(1);
        if ((++sp & 255u) == 0u) { if (xb_ld(&bar[XB_TMO])) break; if (sp > XB_SPIN_CAP) { atomicAdd(&bar[XB_TMO], 1u); break; } }
    }
    nloc = mine > 0u ? mine : 1u; nx = cnt > 0u ? cnt : 1u;
}

__device__ __forceinline__ void xcd_barrier(const XcdBarrier& b) {
    asm volatile("s_waitcnt vmcnt(0)" ::: "memory");
    __syncthreads();
    if (threadIdx.x == 0) {
        unsigned* bar = b.bar;
        __builtin_amdgcn_s_waitcnt(0);
        unsigned nloc = b.st[0], nx = b.st[1];
        if (nloc == 0u) { xcd_barrier_complete(bar, b.x, nloc, nx); b.st[0] = nloc; b.st[1] = nx; }
        const unsigned old = xb_add(&bar[XB_XSUB(b.x)], 1u);
        const unsigned gen = old / nloc;
        if (old + 1u == (gen + 1u) * nloc) {
            __builtin_amdgcn_fence(__ATOMIC_RELEASE, "agent");
            asm volatile("s_waitcnt vmcnt(0)" ::: "memory");
            const unsigned og = xb_add(&bar[XB_TOP], 1u);
            const unsigned tg = og / nx;
            if (og + 1u == (tg + 1u) * nx) xb_add(&bar[XB_TOPGEN], 1u);
            else XB_SPIN(xb_ld(&bar[XB_TOPGEN]) == tg, bar);
            __builtin_amdgcn_fence(__ATOMIC_ACQUIRE, "agent");
            xb_add(&bar[XB_XGEN(b.x)], 1u);
            asm volatile("s_waitcnt vmcnt(0)" ::: "memory");
        } else {
            XB_SPIN(xb_ld(&bar[XB_XGEN(b.x)]) == gen, bar);
            __builtin_amdgcn_fence(__ATOMIC_ACQUIRE, "agent");
            asm volatile("s_waitcnt vmcnt(0)" ::: "memory");
        }
    }
    __syncthreads();
}

__global__ void __launch_bounds__(512, 2) hybrid_fwd(Args args) {
    extern __shared__ __attribute__((aligned(16))) unsigned char lds_raw[];
    LAS unsigned char* lds = (LAS unsigned char*)lds_raw;
#define OPQ int tid = threadIdx.x; asm volatile("" : "+v"(tid)); const int lane = tid & 63, wave = __builtin_amdgcn_readfirstlane(tid >> 6); (void)lane; (void)wave;
    unsigned char* ws = args.ws;
    const int lo = args.ph_lo, hi = args.ph_hi;
    int ph = 0;
    if (threadIdx.x < 16) ((LAS unsigned*)(lds + LDS_MISC))[threadIdx.x] = 0u;
    __syncthreads();
    XcdBarrier xbar; xbar.bar = (unsigned*)ws; xbar.x = 0; xbar.st = nullptr;
    if (hi - lo > 1) xbar = xcd_barrier_post((unsigned*)ws, (volatile LAS unsigned*)(lds + LDS_MISC));
#define IN(k) (lo <= (k) && (k) < hi)
#ifndef PROBE_MASK
#define PROBE_MASK 0
#endif
#define REPS(i) ((((PROBE_MASK) >> (i)) & 1) ? 2 : 1)
#define SUBREP(b) for (int sr_ = 0; sr_ < ((((PROBE_MASK) >> (b)) & 1) ? 2 : 1); ++sr_)
#ifdef ONLY_SITE
#define SITE(i) ((i) == ONLY_SITE)
#else
#define SITE(i) true
#endif
#define SEAM(k) do { if (IN(k) && IN((k) + 1)) { if ((k) == 0) cg::this_grid().sync(); else xcd_barrier(xbar); } } while (0)
    bf16_t* Z = (bf16_t*)(ws + WS_Z); bf16_t* SG = (bf16_t*)(ws + WS_SG); bf16_t* CB = (bf16_t*)(ws + WS_C); bf16_t* HID = (bf16_t*)(ws + WS_Z);
    if (SITE(1) && IN(0)) for (int rp_ = 0; rp_ < REPS(1); ++rp_) { OPQ prologue_a(args, lds, tid, lane, wave); } SEAM(0);
    if (SITE(2) && IN(1)) for (int rp_ = 0; rp_ < REPS(2); ++rp_) { OPQ prologue_b(args, tid); bias_gemv(args, lane, wave);
        norm_prep0(args.in[0], args.in[4], (const float*)(ws + WS_MODV), 1024, CB, (float*)(ws + WS_ROWSS), lane, wave); } SEAM(1);
    for (int l = 0; l < 2; ++l) {
        ph = 2 + l * NPH_LAYER;
        const float* mod = (const float*)(ws + WS_MODV) + (size_t)l * 8 * 6144;
        const float* xin = (l == 0) ? args.in[0] : args.out;
        if (SITE(4) && IN(ph)) for (int rp_ = 0; rp_ < REPS(4); ++rp_) { OPQ
            pg8::Gemm g{CB, (const bf16_t*)(ws + WS_WIN) + (size_t)l * NINP * 1024, NTOK, NINP, 1024, 1024, 1024}; pg8::StaticOrder S; S.init(NTOK, NINP, gridDim.x, blockIdx.x);
            pg8::EpiIn E{Z, SG, (float*)(ws + WS_G32), (const float*)(ws + WS_BIASB_IN) + (size_t)l * 8 * 5888, (const float*)(ws + WS_ROWSS) + (size_t)(2 * l) * NTOK};
            pg8::gemm_phase<pg8::EpiIn, pg8::StaticOrder, true, true>(lds, g, S, E); } SEAM(ph); ++ph;
        if (SITE(5) && IN(ph)) for (int rp_ = 0; rp_ < REPS(5); ++rp_) { OPQ SUBREP(16) scalars_phase(args, lds, tid, lane, wave); qk_norms(args, l, lds, tid); __syncthreads(); SUBREP(17) s5_pass1(args, l, lds, tid, lane, wave); __syncthreads(); SUBREP(18) mlstm_qk(args, l, lds, tid, lane, wave); } SEAM(ph); ++ph;
        if (SITE(6) && IN(ph)) for (int rp_ = 0; rp_ < REPS(6); ++rp_) { OPQ SUBREP(19) s5_pass2(args, l, lds, tid, lane, wave); SUBREP(20) mlstm_localkv(args, lds, tid, lane, wave); } SEAM(ph); ++ph;
        if (SITE(7) && IN(ph)) for (int rp_ = 0; rp_ < REPS(7); ++rp_) { OPQ mlstm_scan(args, tid); SUBREP(21) s5_pass3(args, l, lds, tid, lane, wave); } SEAM(ph); ++ph;
        if (SITE(8) && IN(ph)) for (int rp_ = 0; rp_ < REPS(8); ++rp_) { OPQ
            pg8::Gemm g{CB + 768, (const bf16_t*)(ws + WS_WGLU) + (size_t)l * 256 * 256, NTOK, 256, 256, 1024, 256}; pg8::StaticOrder S; S.init(NTOK, 256, gridDim.x, blockIdx.x);
            pg8::EpiGlu E{CB, Z};
            pg8::gemm_phase<pg8::EpiGlu, pg8::StaticOrder, false, true>(lds, g, S, E); }
        if (SITE(9) && IN(ph)) for (int rp_ = 0; rp_ < REPS(9); ++rp_) { OPQ
            const int G = gridDim.x, bx = blockIdx.x, vcu = (G % 8 == 0) ? (bx % 8) * (G / 8) + bx / 8 : bx;
            const attn_body::bf16* Zb = (const attn_body::bf16*)Z;
#ifndef NO_ATTN
            const int vb = (int)(((long)vcu * 8) / G) & 7; unsigned* qh = (unsigned*)(ws + WS_AQ) + (l * 8 + vb) * 64;
            volatile LAS unsigned* nxt = (volatile LAS unsigned*)(lds + LDS_MISC + 32);
            for (;;) {
                if (tid == 0) *nxt = __hip_atomic_fetch_add(qh, 1u, __ATOMIC_RELAXED, __HIP_MEMORY_SCOPE_AGENT);
                __syncthreads();
                const int uq = (int)*nxt;
                __syncthreads();
                if (uq >= 192) break;
                const int b = vb, qb = 31 - uq / 6, h = uq % 6, bh = b * 6 + h;
                const float* fb = (const float*)(ws + WS_FB) + (size_t)bh * SEQL;
                const unsigned* nr = (const unsigned*)(ws + WS_NRM) + l * 96 + bh * 2;
                const float thr = 2.02f * sqrtf(__uint_as_float(nr[0]) * __uint_as_float(nr[1])) + 172.f;
                const int q0 = qb * 256, NT = 4 * (qb + 1); const float lim = fb[q0] - thr;
                const int j0 = lane, j1 = lane + 64;
                const bool ok0 = (j0 < NT - 4) && (fb[64 * j0 + 63] < lim), ok1 = (j1 < NT - 4) && (fb[64 * j1 + 63] < lim);
                int t0 = (__popcll(__ballot(ok0)) + __popcll(__ballot(ok1))) & ~1; t0 = __builtin_amdgcn_readfirstlane(t0);
                attn_body::attn_unit<16>(b, h, qb, t0, Zb + ZC_FQ, Zb + ZC_FK, Zb + ZC_FV, (attn_body::bf16*)Z + ZC_FQ, fb, (char*)lds_raw); }
#endif
            __syncthreads();
#ifndef NO_MOUT
            SUBREP(23) mlstm_out(args, l, lds, tid, lane, wave, ((((PROBE_MASK) >> 23) & 1) && sr_ == 0) ? (ZC_MQK - ZC_MO) : 0);
#endif
 } SEAM(ph); ++ph;
        if (SITE(10) && IN(ph)) for (int rp_ = 0; rp_ < REPS(10); ++rp_) { OPQ
            pg8::Gemm g{Z, (const bf16_t*)(ws + WS_WMG) + (size_t)l * 1024 * 1024, NTOK, 1024, 1024, ZP, 1024}; pg8::StaticOrder S; S.init(NTOK, 1024, gridDim.x, blockIdx.x);
            pg8::EpiMerge E{SG, CB};
            pg8::gemm_phase<pg8::EpiMerge, pg8::StaticOrder, true, true>(lds, g, S, E); } SEAM(ph); ++ph;
        if (SITE(11) && IN(ph)) for (int rp_ = 0; rp_ < REPS(11); ++rp_) { OPQ
            pg8::Gemm g{CB, (const bf16_t*)(ws + WS_WOUT) + (size_t)l * 1024 * 1024, NTOK, 1024, 1024, 1024, 1024}; pg8::StaticOrder S; S.init(NTOK, 1024, gridDim.x, blockIdx.x);
            bf16_t* XB = (bf16_t*)args.out;
            if (l == 0) { pg8::EpiRes<false> E{args.in[0], XB, mod + 2048, (bf16_t*)(ws + WS_XT2), args.in[5] + l * 1024, mod + 4096, (float*)(ws + WS_ROWSS) + (size_t)(2 * l + 1) * NTOK};
                pg8::gemm_phase<pg8::EpiRes<false>, pg8::StaticOrder, true, true>(lds, g, S, E); }
            else { pg8::EpiRes<true> E{XB, XB, mod + 2048, (bf16_t*)(ws + WS_XT2), args.in[5] + l * 1024, mod + 4096, (float*)(ws + WS_ROWSS) + (size_t)(2 * l + 1) * NTOK};
                pg8::gemm_phase<pg8::EpiRes<true>, pg8::StaticOrder, true, true>(lds, g, S, E); } } SEAM(ph); ++ph;
        if (SITE(13) && IN(ph)) for (int rp_ = 0; rp_ < REPS(13); ++rp_) { OPQ
            pg8::Gemm g{(const bf16_t*)(ws + WS_XT2), (const bf16_t*)(ws + WS_W13) + (size_t)l * 5632 * 1024, NTOK, 5632, 1024, 1024, 1024}; pg8::StaticOrder S; S.init(NTOK, 5632, gridDim.x, blockIdx.x);
            pg8::EpiFfn1 E{HID, (const float*)(ws + WS_BIASB_F) + (size_t)l * 8 * 5632, (const float*)(ws + WS_ROWSS) + (size_t)(2 * l + 1) * NTOK};
            pg8::gemm_phase<pg8::EpiFfn1, pg8::StaticOrder, true, true>(lds, g, S, E); } SEAM(ph); ++ph;
        if (SITE(14) && IN(ph)) for (int rp_ = 0; rp_ < REPS(14); ++rp_) { OPQ
            pg8::Gemm g{HID, (const bf16_t*)(ws + WS_W2) + (size_t)l * 1024 * FFH, NTOK, 1024, FFH, FFH, FFH}; pg8::StaticOrder S; S.init(NTOK, 1024, gridDim.x, blockIdx.x, 1);
            bf16_t* XB = (bf16_t*)args.out;
            pg8::EpiRes<true> E{XB, (l == 0) ? XB : (bf16_t*)nullptr, mod + 5120, CB, (l == 0) ? args.in[4] + 1024 : args.in[29], (l == 0) ? mod + 8 * 6144 + 1024 : (const float*)nullptr,
                                (l == 0) ? (float*)(ws + WS_ROWSS) + (size_t)2 * NTOK : (float*)(ws + WS_ROWSS4)};
            pg8::gemm_phase<pg8::EpiRes<true>, pg8::StaticOrder, true, true>(lds, g, S, E); } SEAM(ph); ++ph;
    }
    ph = 2 + 2 * NPH_LAYER;
    if (SITE(15) && IN(ph)) for (int rp_ = 0; rp_ < REPS(15); ++rp_) { OPQ norm_final2(CB, (const float*)(ws + WS_ROWSS4), args.out, lane, wave); }
#undef IN
#undef SEAM
}

extern "C" void kernel_launch(void* const* d_in, const int* in_sizes, int n_in, void* d_out, int out_size, void* d_ws, size_t ws_size, hipStream_t stream) {
    static int grid = 0;
    if (grid == 0) {
        if (n_in != 30 || ws_size < WS_END) { fprintf(stderr, "kernel_launch: n_in %d ws %zu (need %zu)\n", n_in, ws_size, (size_t)WS_END); grid = -1; return; }
        int dev = 0, cus = 0, per_cu = 0;
        hipGetDevice(&dev); hipDeviceGetAttribute(&cus, hipDeviceAttributeMultiprocessorCount, dev);
        hipFuncSetAttribute((const void*)hybrid_fwd, hipFuncAttributeMaxDynamicSharedMemorySize, LDS_TOTAL);
        hipOccupancyMaxActiveBlocksPerMultiprocessor(&per_cu, (const void*)hybrid_fwd, 512, LDS_TOTAL);
        (void)hipGetLastError();
        if (per_cu < 1) per_cu = 1;
        grid = cus;
    }
    if (grid < 0) return;
    Args a{};
    for (int i = 0; i < 30; ++i) a.in[i] = (const float*)d_in[i];
    a.out = (float*)d_out; a.ws = (unsigned char*)d_ws;
#if MK_PER_PHASE
    for (int p = 0; p < NPHASES; ++p) { a.ph_lo = p; a.ph_hi = p + 1; hipLaunchKernelGGL(hybrid_fwd, dim3(grid), dim3(512), LDS_TOTAL, stream, a); }
#else
    a.ph_lo = 0; a.ph_hi = NPHASES;
    (void)hipMemsetAsync(d_ws, 0, 16384, stream);
    void* kargs[] = {&a};
    hipError_t e = hipLaunchCooperativeKernel((const void*)hybrid_fwd, dim3(grid), dim3(512), kargs, LDS_TOTAL, stream);
    if (e != hipSuccess) fprintf(stderr, "cooperative launch failed: %s (grid %d)\n", hipGetErrorString(e), grid);
#endif
}
```

```cpp
#define MK_PER_PHASE 0
#include <hip/hip_runtime.h>
#include <hip/hip_cooperative_groups.h>
#include <cstdio>
#include <cstdint>
namespace pg8 {
#define PG8_LAS __attribute__((address_space(3)))
typedef unsigned short bf16_t;
typedef short bf16x8 __attribute__((ext_vector_type(8)));
typedef float f32x4 __attribute__((ext_vector_type(4)));
typedef unsigned u32x4 __attribute__((ext_vector_type(4)));
constexpr int BM = 256, BK = 64, HALF = 128, HTB = HALF * BK * 2  , STAGE_BYTES = 8 * HTB, NXCD = 8, WGM = 4;

__host__ __device__ __forceinline__ int lds_byte(int r, int c) { const int st = (r >> 4) * 2 + (c >> 5), rr = r & 15, cc = c & 31, ob = rr * 64 + cc * 2; return st * 1024 + (ob ^ (((ob >> 9) & 1) << 5)); }
__host__ __device__ __forceinline__ void stage_rc(int b, int& R, int& C) { const int st = b / 1024, sb = b % 1024, swz = sb ^ (((sb >> 9) & 1) << 5); R = (st >> 1) * 16 + swz / 64; C = (st & 1) * 32 + (swz % 64) / 2; }
__host__ __device__ __forceinline__ int perm32(int rho) { const int n = rho >> 4, i = rho & 15; return 8 * (i >> 2) + 4 * n + (i & 3); }

struct Unit { int pm, pn; };
struct Gemm { const bf16_t* A; const bf16_t* Bt; int M, N, K, lda, ldb; };

struct StaticOrder {
    int nM, nN, nwg, G, c, rev;
    __host__ __device__ void init(int M, int N, int G_, int c_, int rev_ = 0) { nM = M / BM; nN = N / BM; nwg = nM * nN; G = G_; c = c_; rev = rev_; }
    __host__ __device__ bool next(int i, Unit& u) const {
        const long L = (long)i * G + c; if (L >= nwg) return false;
        int wgid = (int)L; { const int q = nwg / NXCD, r = nwg % NXCD, xcd = wgid % NXCD, off = wgid / NXCD; wgid = (xcd < r ? xcd * (q + 1) : r * (q + 1) + (xcd - r) * q) + off; }
        const int nig = WGM * nN, gid = wgid / nig, fm = gid * WGM, gsz = (nM - fm) < WGM ? (nM - fm) : WGM;
        u.pm = fm + ((wgid % nig) % gsz); u.pn = (wgid % nig) / gsz; if (rev) { const int cs = nM / NXCD; u.pm = (u.pm / cs) * cs + (cs - 1 - u.pm % cs); } return true;
    }
    __device__ __forceinline__ void a_ready(const Unit&) const {}
    __device__ __forceinline__ void done(const Unit&) const {}
};

__device__ __forceinline__ unsigned cvt_pk_bf16(float lo, float hi) { unsigned r; asm volatile("v_cvt_pk_bf16_f32 %0, %1, %2" : "=v"(r) : "v"(lo), "v"(hi)); return r; }
typedef float f32x2 __attribute__((ext_vector_type(2)));


template <class Epi, class Sched, bool ALIGN_EPI = false, bool SP2 = false>
__device__ __forceinline__ void gemm_phase(PG8_LAS unsigned char* lds, const Gemm g, const Sched& S, const Epi& E) {
    int tid_o = threadIdx.x; asm volatile("" : "+v"(tid_o));
    const int tid = tid_o, wid = __builtin_amdgcn_readfirstlane(tid >> 6), lane = tid & 63, wr = wid >> 2, wc = wid & 3, fr = lane & 15, fq = lane >> 4;
    const int K = g.K; int nt = K / BK; asm volatile("" : "+s"(nt));
    unsigned voffA[2], voffB[2];
#pragma unroll
    for (int i = 0; i < 2; ++i) { int R, C; stage_rc(tid * 16 + i * 8192, R, C); const int Rb = Epi::PERM ? ((R & ~31) + perm32(R & 31)) : R;
        voffA[i] = (unsigned)(R * g.lda + C) * 2u; voffB[i] = (unsigned)(Rb * g.ldb + C) * 2u; }
    const size_t kstep = (size_t)(BK * 2);
    const size_t hstepA = (size_t)HALF * g.lda * 2, hstepB = (size_t)HALF * g.ldb * 2;
    const size_t tstepA = 2 * hstepA, tstepB = 2 * hstepB;
    const unsigned ldsw = (unsigned)wid * 1024u;
    const int aoff = lds_byte(wr * 64 + fr, fq * 8), boff = lds_byte(wc * 32 + fr, fq * 8);
#define PG8_SA(b, h) (((b) * 2 + (h)) * HTB)
#define PG8_SB(b, h) ((4 + (b) * 2 + (h)) * HTB)
#define PG8_STAGE(bufoff, gbase, voff) do { _Pragma("unroll") for (int _i = 0; _i < 2; ++_i) \
        __builtin_amdgcn_global_load_lds((const unsigned*)((const char*)(gbase) + (voff)[_i]), (PG8_LAS unsigned*)(lds + (bufoff) + ldsw + _i * 8192), 16, 0, 0); } while (0)
#define PG8_LDA(dst, b, h) do { _Pragma("unroll") for (int m = 0; m < 4; ++m) _Pragma("unroll") for (int k = 0; k < 2; ++k) dst[m][k] = *(const PG8_LAS bf16x8*)(lds + PG8_SA(b, h) + aoff + m * 2048 + k * 1024); } while (0)
#define PG8_LDB(dst, b, h) do { _Pragma("unroll") for (int n = 0; n < 2; ++n) _Pragma("unroll") for (int k = 0; k < 2; ++k) dst[n][k] = *(const PG8_LAS bf16x8*)(lds + PG8_SB(b, h) + boff + n * 2048 + k * 1024); } while (0)
#define PG8_MMA(ai, bj, At, Bt) do { __builtin_amdgcn_s_setprio(1); _Pragma("unroll") for (int m = 0; m < 4; ++m) _Pragma("unroll") for (int n = 0; n < 2; ++n) _Pragma("unroll") for (int k = 0; k < 2; ++k) \
        acc[ai][bj][m][n] = __builtin_amdgcn_mfma_f32_16x16x32_bf16(Bt[n][k], At[m][k], acc[ai][bj][m][n], 0, 0, 0); __builtin_amdgcn_s_setprio(0); } while (0)
#define PG8_WAIT_V(n) asm volatile("s_waitcnt vmcnt(" #n ")" ::: "memory")
#define PG8_WAIT_L(n) asm volatile("s_waitcnt lgkmcnt(" #n ")" ::: "memory")
#define PG8_BAR __builtin_amdgcn_s_barrier()
#define PG8_SCHED __builtin_amdgcn_sched_barrier(0)
    Unit cur, nxt; int ui = 0;
    if (!S.next(0, cur)) return;
    f32x4 acc[2][2][4][2];
#pragma unroll
    for (int a = 0; a < 2; ++a)
#pragma unroll
        for (int b = 0; b < 2; ++b)
#pragma unroll
            for (int m = 0; m < 4; ++m)
#pragma unroll
                for (int n = 0; n < 2; ++n) acc[a][b][m][n] = (f32x4){0.f, 0.f, 0.f, 0.f};
    bf16x8 At[4][2], B0[2][2], B1[2][2];
    const char* cA = (const char*)g.A + (size_t)cur.pm * tstepA; const char* cB = (const char*)g.Bt + (size_t)cur.pn * tstepB;
    S.a_ready(cur);
    if constexpr (SP2) {
        PG8_STAGE(PG8_SB(0, 0), cB, voffB); PG8_STAGE(PG8_SB(0, 1), cB + hstepB, voffB); PG8_STAGE(PG8_SA(0, 0), cA, voffA); PG8_STAGE(PG8_SA(0, 1), cA + hstepA, voffA);
        if (wr == 1) PG8_BAR;
        PG8_WAIT_V(2); PG8_BAR;
        PG8_STAGE(PG8_SB(1, 0), cB + kstep, voffB); PG8_STAGE(PG8_SA(1, 0), cA + kstep, voffA); PG8_STAGE(PG8_SB(1, 1), cB + hstepB + kstep, voffB);
        PG8_WAIT_V(6); PG8_BAR;
    } else {
        PG8_STAGE(PG8_SB(0, 0), cB, voffB); PG8_STAGE(PG8_SA(0, 0), cA, voffA); PG8_STAGE(PG8_SB(0, 1), cB + hstepB, voffB); PG8_STAGE(PG8_SA(0, 1), cA + hstepA, voffA);
        if (wr == 1) PG8_BAR;
        PG8_WAIT_V(4); PG8_BAR;
        PG8_STAGE(PG8_SB(1, 0), cB + kstep, voffB); PG8_STAGE(PG8_SA(1, 0), cA + kstep, voffA); PG8_STAGE(PG8_SB(1, 1), cB + hstepB + kstep, voffB);
        PG8_WAIT_V(6); PG8_BAR;
    }
    for (;;) {
        const bool has_next = S.next(ui + 1, nxt);
        const char* nA = has_next ? (const char*)g.A + (size_t)nxt.pm * tstepA : cA; const char* nB = has_next ? (const char*)g.Bt + (size_t)nxt.pn * tstepB : cB;
        for (int t = 0; t < nt; t += 2) {
            const bool last = (t == nt - 2);
            const char* a1 = cA + (size_t)(t + 1) * kstep;
            const char* a2 = last ? nA : cA + (size_t)(t + 2) * kstep; const char* b2 = last ? nB : cB + (size_t)(t + 2) * kstep;
            const char* a3 = a2 + kstep; const char* b3 = b2 + kstep;
            if (last && has_next) S.a_ready(nxt);
            if constexpr (SP2) {
            PG8_LDB(B0, 0, 0); PG8_LDB(B1, 0, 1); PG8_SCHED; PG8_LDA(At, 0, 0); PG8_STAGE(PG8_SA(1, 1), a1 + hstepA, voffA);
            PG8_WAIT_V(8); PG8_WAIT_L(0); PG8_BAR; PG8_MMA(0, 0, At, B0); PG8_MMA(0, 1, At, B1); PG8_BAR; PG8_SCHED;
            PG8_LDA(At, 0, 1); PG8_STAGE(PG8_SB(0, 0), b2, voffB); PG8_STAGE(PG8_SB(0, 1), b2 + hstepB, voffB); PG8_STAGE(PG8_SA(0, 0), a2, voffA);
            PG8_WAIT_V(8); PG8_WAIT_L(0); PG8_BAR; PG8_MMA(1, 0, At, B0); PG8_MMA(1, 1, At, B1); PG8_BAR; PG8_SCHED;
            PG8_LDB(B0, 1, 0); PG8_LDB(B1, 1, 1); PG8_SCHED; PG8_LDA(At, 1, 0); PG8_STAGE(PG8_SA(0, 1), a2 + hstepA, voffA);
            PG8_WAIT_V(8); PG8_WAIT_L(0); PG8_BAR; PG8_MMA(0, 0, At, B0); PG8_MMA(0, 1, At, B1); PG8_BAR; PG8_SCHED;
            PG8_LDA(At, 1, 1); PG8_STAGE(PG8_SB(1, 0), b3, voffB); PG8_STAGE(PG8_SB(1, 1), b3 + hstepB, voffB); PG8_STAGE(PG8_SA(1, 0), a3, voffA);
            PG8_WAIT_V(8); PG8_WAIT_L(0); PG8_BAR; PG8_MMA(1, 0, At, B0); PG8_MMA(1, 1, At, B1); PG8_BAR; PG8_SCHED;
            } else {
            PG8_LDB(B0, 0, 0); PG8_SCHED; PG8_LDA(At, 0, 0); PG8_STAGE(PG8_SA(1, 1), a1 + hstepA, voffA);
            PG8_WAIT_L(8); PG8_BAR; PG8_WAIT_L(0); PG8_MMA(0, 0, At, B0); PG8_BAR; PG8_SCHED;
            PG8_LDB(B1, 0, 1); PG8_STAGE(PG8_SB(0, 0), b2, voffB);
            PG8_BAR; PG8_WAIT_L(0); PG8_MMA(0, 1, At, B1); PG8_BAR;
            PG8_LDA(At, 0, 1); PG8_STAGE(PG8_SA(0, 0), a2, voffA);
            PG8_BAR; PG8_WAIT_L(0); PG8_MMA(1, 0, At, B0); PG8_BAR; PG8_SCHED;
            PG8_STAGE(PG8_SB(0, 1), b2 + hstepB, voffB);
            PG8_WAIT_V(6); PG8_BAR; PG8_MMA(1, 1, At, B1); PG8_BAR;
            PG8_LDB(B0, 1, 0); PG8_SCHED; PG8_LDA(At, 1, 0); PG8_STAGE(PG8_SA(0, 1), a2 + hstepA, voffA);
            PG8_WAIT_L(8); PG8_BAR; PG8_WAIT_L(0); PG8_MMA(0, 0, At, B0); PG8_BAR; PG8_SCHED;
            PG8_LDB(B1, 1, 1); PG8_STAGE(PG8_SB(1, 0), b3, voffB);
            PG8_BAR; PG8_WAIT_L(0); PG8_MMA(0, 1, At, B1); PG8_BAR;
            PG8_LDA(At, 1, 1); PG8_STAGE(PG8_SA(1, 0), a3, voffA);
            PG8_BAR; PG8_WAIT_L(0); PG8_MMA(1, 0, At, B0); PG8_BAR; PG8_SCHED;
            PG8_STAGE(PG8_SB(1, 1), b3 + hstepB, voffB);
            PG8_WAIT_V(6); PG8_BAR; PG8_MMA(1, 1, At, B1); PG8_BAR;
            }
            if constexpr (Epi::HAS_MID) { if (t + 2 == 4 || t + 2 == 10) E.mid(acc, cur, t + 2, wr, wc, fr, fq); }
        }
        if constexpr (ALIGN_EPI) { if (wr == 0) PG8_BAR; }
        if constexpr (!Epi::AFTER_DRAIN) { E(acc, cur, wr, wc, fr, fq); S.done(cur); }
        if (!has_next) break;
#pragma unroll
        for (int a = 0; a < 2; ++a)
#pragma unroll
            for (int b = 0; b < 2; ++b)
#pragma unroll
                for (int m = 0; m < 4; ++m)
#pragma unroll
                    for (int n = 0; n < 2; ++n) acc[a][b][m][n] = (f32x4){0.f, 0.f, 0.f, 0.f};
        cur = nxt; cA = nA; cB = nB; ++ui;
        if constexpr (ALIGN_EPI) { if (wr == 1) PG8_BAR; }
    }
    PG8_WAIT_V(0);
    if constexpr (!ALIGN_EPI) { if (wr == 0) PG8_BAR; }
    PG8_BAR;
#undef PG8_SA
#undef PG8_SB
#undef PG8_STAGE
#undef PG8_LDA
#undef PG8_LDB
#undef PG8_MMA
#undef PG8_WAIT_V
#undef PG8_WAIT_L
#undef PG8_BAR
#undef PG8_SCHED
}
}
namespace pg8 {
__device__ __forceinline__ float bflo(unsigned w) { return __uint_as_float(w << 16); }
__device__ __forceinline__ float bfhi(unsigned w) { return __uint_as_float(w & 0xffff0000u); }
__device__ __forceinline__ u32x4 pack8(const f32x4 a, const f32x4 b) { u32x4 w; w.x = cvt_pk_bf16(a[0], a[1]); w.y = cvt_pk_bf16(a[2], a[3]); w.z = cvt_pk_bf16(b[0], b[1]); w.w = cvt_pk_bf16(b[2], b[3]); return w; }
__device__ __forceinline__ void unpack8(const u32x4 w, f32x4& a, f32x4& b) { a = (f32x4){bflo(w.x), bfhi(w.x), bflo(w.y), bfhi(w.y)}; b = (f32x4){bflo(w.z), bfhi(w.z), bflo(w.w), bfhi(w.w)}; }
__device__ __forceinline__ float sigm(float x) { return __builtin_amdgcn_rcpf(1.f + __expf(-x)); }

struct EpiIn {
    static constexpr bool PERM = true, AFTER_DRAIN = false, HAS_MID = false;
    bf16_t* Z; bf16_t* SG; float* G32; const float* bias; const float* rowss;
    __device__ __forceinline__ void operator()(const f32x4 (&acc)[2][2][4][2], const Unit& u, int wr, int wc, int fr, int fq) const {
        const int row0 = u.pm * BM + wr * 64 + fr, colt = u.pn * BM + wc * 32 + 8 * fq;
        const float* bp = bias + (size_t)((u.pm * BM) >> 13) * 5888;
        float rs[2][4];
#pragma unroll
        for (int ai = 0; ai < 2; ++ai)
#pragma unroll
            for (int m = 0; m < 4; ++m) rs[ai][m] = rsqrtf(rowss[row0 + ai * HALF + m * 16] * (1.f / 1024.f) + 1e-6f);
#pragma unroll
        for (int bj = 0; bj < 2; ++bj) { const int col = colt + bj * HALF; const f32x4 b0 = *(const f32x4*)(bp + col), b1 = *(const f32x4*)(bp + col + 4);
#pragma unroll
            for (int ai = 0; ai < 2; ++ai)
#pragma unroll
                for (int m = 0; m < 4; ++m) { const size_t row = (size_t)(row0 + ai * HALF + m * 16); f32x4 v0 = acc[ai][bj][m][0] * rs[ai][m] + b0, v1 = acc[ai][bj][m][1] * rs[ai][m] + b1;
                    if (u.pn < 10) { *(u32x4*)(Z + row * 2560 + col) = pack8(v0, v1); }
                    else if (u.pn == 10) { if (col < 2560 + 16) { *(f32x4*)(G32 + row * 16 + (col - 2560)) = v0; *(f32x4*)(G32 + row * 16 + (col - 2560) + 4) = v1; } }
                    else {
#pragma unroll
                        for (int i = 0; i < 4; ++i) { v0[i] = fmaxf(sigm(v0[i]), 1e-18f); v1[i] = fmaxf(sigm(v1[i]), 1e-18f); }
                        *(u32x4*)(SG + row * 3072 + (col - 2816)) = pack8(v0, v1); } } }
    }
};
struct EpiMerge {
    static constexpr bool PERM = true, AFTER_DRAIN = false, HAS_MID = true;
    const bf16_t* SG; bf16_t* MG;
    __device__ __forceinline__ void mid(f32x4 (&acc)[2][2][4][2], const Unit& u, int kdone, int wr, int wc, int fr, int fq) const {
        const int noff = (kdone == 4) ? 0 : 1024, doff = noff + 1024;
        int fro = fr; asm volatile("" : "+v"(fro));
        const int row0 = u.pm * BM + wr * 64 + fro, colt = u.pn * BM + wc * 32 + 8 * fq;
#pragma unroll
        for (int ai = 0; ai < 2; ++ai) { u32x4 nv[4][2], dv[4][2];
#pragma unroll
            for (int m = 0; m < 4; ++m) { const bf16_t* sp = SG + (size_t)(row0 + ai * HALF + m * 16) * 3072 + colt;
#pragma unroll
                for (int bj = 0; bj < 2; ++bj) { nv[m][bj] = *(const u32x4*)(sp + noff + bj * HALF); dv[m][bj] = *(const u32x4*)(sp + doff + bj * HALF); } }
#pragma unroll
            for (int m = 0; m < 4; ++m)
#pragma unroll
                for (int bj = 0; bj < 2; ++bj) { f32x4 n0, n1, d0, d1; unpack8(nv[m][bj], n0, n1); unpack8(dv[m][bj], d0, d1);
#pragma unroll
                    for (int i = 0; i < 4; ++i) { acc[ai][bj][m][0][i] *= n0[i] * __builtin_amdgcn_rcpf(d0[i]); acc[ai][bj][m][1][i] *= n1[i] * __builtin_amdgcn_rcpf(d1[i]); } }
            asm volatile("" ::: "memory"); }
    }
    __device__ __forceinline__ void operator()(const f32x4 (&acc)[2][2][4][2], const Unit& u, int wr, int wc, int fr, int fq) const {
        const int row0 = u.pm * BM + wr * 64 + fr, colt = u.pn * BM + wc * 32 + 8 * fq;
#pragma unroll
        for (int ai = 0; ai < 2; ++ai) { u32x4 gv[4][2];
#pragma unroll
            for (int m = 0; m < 4; ++m)
#pragma unroll
                for (int bj = 0; bj < 2; ++bj) gv[m][bj] = *(const u32x4*)(SG + (size_t)(row0 + ai * HALF + m * 16) * 3072 + 2048 + colt + bj * HALF);
#pragma unroll
            for (int m = 0; m < 4; ++m)
#pragma unroll
                for (int bj = 0; bj < 2; ++bj) { f32x4 g0, g1; unpack8(gv[m][bj], g0, g1);
                    *(u32x4*)(MG + (size_t)(row0 + ai * HALF + m * 16) * 1024 + colt + bj * HALF) = pack8(acc[ai][bj][m][0] * g0, acc[ai][bj][m][1] * g1); }
            asm volatile("" ::: "memory"); }
    }
};
template <bool INBF> struct EpiRes {
    static constexpr bool PERM = true, AFTER_DRAIN = false, HAS_MID = false;
    const void* xin; bf16_t* xb; const float* gate; bf16_t* XT; const float* ng; const float* msc; float* rowss;
    __device__ __forceinline__ void operator()(const f32x4 (&acc)[2][2][4][2], const Unit& u, int wr, int wc, int fr, int fq) const {
        const int row0 = u.pm * BM + wr * 64 + fr, colt = u.pn * BM + wc * 32 + 8 * fq;
        const size_t bo = (size_t)((u.pm * BM) >> 13) * 6144; const float* gp = gate + bo; const float* mp = msc ? msc + bo : nullptr;
#pragma unroll
        for (int aim = 0; aim < 4; ++aim) { const int ai = aim >> 1, mb = (aim & 1) * 2; f32x4 xr[4][2][2];
#pragma unroll
            for (int m = mb; m < mb + 2; ++m)
#pragma unroll
                for (int bj = 0; bj < 2; ++bj) { const size_t off = (size_t)(row0 + ai * HALF + m * 16) * 1024 + colt + bj * HALF;
                    if (INBF) { const u32x4 w = *(const u32x4*)((const bf16_t*)xin + off); unpack8(w, xr[m][bj][0], xr[m][bj][1]); }
                    else { xr[m][bj][0] = *(const f32x4*)((const float*)xin + off); xr[m][bj][1] = *(const f32x4*)((const float*)xin + off + 4); } }
#pragma unroll
            for (int m = mb; m < mb + 2; ++m) { const int row = row0 + ai * HALF + m * 16; float ss = 0.f;
#pragma unroll
                for (int bj = 0; bj < 2; ++bj) { const int col = colt + bj * HALF; const size_t off = (size_t)row * 1024 + col;
                    const f32x4 g0 = *(const f32x4*)(gp + col), g1 = *(const f32x4*)(gp + col + 4);
                    const f32x4 x0 = xr[m][bj][0] + g0 * acc[ai][bj][m][0], x1 = xr[m][bj][1] + g1 * acc[ai][bj][m][1];
                    if (xb) *(u32x4*)(xb + off) = pack8(x0, x1);
                    ss += (x0[0] * x0[0] + x0[1] * x0[1]) + (x0[2] * x0[2] + x0[3] * x0[3]) + (x1[0] * x1[0] + x1[1] * x1[1]) + (x1[2] * x1[2] + x1[3] * x1[3]);
                    f32x4 n0 = *(const f32x4*)(ng + col), n1 = *(const f32x4*)(ng + col + 4);
                    if (mp) { n0 = n0 * (*(const f32x4*)(mp + col) + 1.f); n1 = n1 * (*(const f32x4*)(mp + col + 4) + 1.f); }
                    *(u32x4*)(XT + off) = pack8(x0 * n0, x1 * n1); }
                ss += __shfl_xor(ss, 16); ss += __shfl_xor(ss, 32); if (fq == 0) unsafeAtomicAdd(rowss + row, ss); }
            asm volatile("" ::: "memory"); }
    }
};
struct EpiFfn1 {
    static constexpr bool PERM = true, AFTER_DRAIN = false, HAS_MID = false;
    bf16_t* HID; const float* bias; const float* rowss;
    __device__ __forceinline__ void operator()(const f32x4 (&acc)[2][2][4][2], const Unit& u, int wr, int wc, int fr, int fq) const {
        const int row0 = u.pm * BM + wr * 64 + fr, hc = u.pn * 128 + wc * 32 + 8 * fq;
        const float* bp = bias + (size_t)((u.pm * BM) >> 13) * 5632 + u.pn * BM + wc * 32 + 8 * fq;
        const f32x4 ba0 = *(const f32x4*)(bp), ba1 = *(const f32x4*)(bp + 4), bb0 = *(const f32x4*)(bp + HALF), bb1 = *(const f32x4*)(bp + HALF + 4);
#pragma unroll
        for (int ai = 0; ai < 2; ++ai)
#pragma unroll
            for (int m = 0; m < 4; ++m) { const size_t row = (size_t)(row0 + ai * HALF + m * 16); f32x4 h0, h1; const float rs = rsqrtf(rowss[row] * (1.f / 1024.f) + 1e-6f);
#pragma unroll
                for (int i = 0; i < 4; ++i) { const float a = acc[ai][0][m][0][i] * rs + ba0[i], b = acc[ai][0][m][1][i] * rs + ba1[i];
                    h0[i] = a * sigm(a) * (acc[ai][1][m][0][i] * rs + bb0[i]); h1[i] = b * sigm(b) * (acc[ai][1][m][1][i] * rs + bb1[i]); }
                *(u32x4*)(HID + row * 2816 + hc) = pack8(h0, h1); }
    }
};
struct EpiGlu {
    static constexpr bool PERM = true, AFTER_DRAIN = false, HAS_MID = false;
    const bf16_t* YG; bf16_t* Z;
    __device__ __forceinline__ void operator()(const f32x4 (&acc)[2][2][4][2], const Unit& u, int wr, int wc, int fr, int fq) const {
        const int row0 = u.pm * BM + wr * 64 + fr, colt = wc * 32 + 8 * fq;
#pragma unroll
        for (int ai = 0; ai < 2; ++ai) { u32x4 yv[4][2];
#pragma unroll
            for (int m = 0; m < 4; ++m)
#pragma unroll
                for (int bj = 0; bj < 2; ++bj) yv[m][bj] = *(const u32x4*)(YG + (size_t)(row0 + ai * HALF + m * 16) * 1024 + 768 + colt + bj * HALF);
#pragma unroll
            for (int m = 0; m < 4; ++m)
#pragma unroll
                for (int bj = 0; bj < 2; ++bj) { f32x4 y0, y1; unpack8(yv[m][bj], y0, y1);
#pragma unroll
                    for (int i = 0; i < 4; ++i) { y0[i] *= sigm(acc[ai][bj][m][0][i]); y1[i] *= sigm(acc[ai][bj][m][1][i]); }
                    *(u32x4*)(Z + (size_t)(row0 + ai * HALF + m * 16) * 2560 + colt + bj * HALF) = pack8(y0, y1); }
            asm volatile("" ::: "memory"); }
    }
};
}
#include <hip/hip_bf16.h>
#include <cmath>
namespace attn_body {
using bf16=__hip_bfloat16;
using bf16x8=__attribute__((ext_vector_type(8)))short;
using s16x4=__attribute__((ext_vector_type(4)))short;
using f32x16=__attribute__((ext_vector_type(16)))float;
using f32x4v=__attribute__((ext_vector_type(4)))float;
using u32x4=__attribute__((ext_vector_type(4)))unsigned;
constexpr int BATCH=8,NHEAD=6,SEQ=8192,D=64,DM=2560;
constexpr int NW=8,QBLK=32,QB=QBLK*NW,KVBLK=64,NQB=SEQ/QB;
constexpr int ATTN_PITCH=DM, ATTN_UNIT_ROWS=QB;
__device__ __forceinline__ int crow(int r,int hi){return (r&3)+8*(r>>2)+4*hi;}
#define SBAR() __builtin_amdgcn_sched_barrier(0)
__device__ __forceinline__ void cmask(f32x16&p0,f32x16&p1,int jb,int qrel,int hi){
  const float NEG=-INFINITY; int d=qrel-4*hi-64*jb; asm volatile("":"+v"(d));
  #pragma unroll
  for(int r=0;r<16;++r){const int c=(r&3)+8*(r>>2); if(c>d)p0[r]=NEG; if(c+32>d)p1[r]=NEG;}
}

constexpr int NSLOT=3, SLOTB=8192;
constexpr int LDS_K=0, LDS_V=NSLOT*SLOTB, LDS_WS=2*NSLOT*SLOTB, LDS_OST=LDS_WS+NW*64*4, LDS_FB=LDS_OST+NW*4096, LDS_BYTES=LDS_FB+SEQ*4;
constexpr float C2=0.125f*1.4426950408889634f;
__device__ __forceinline__ void glds16(const void*gsrc,unsigned lds_dst){unsigned keep;
  asm volatile("s_mov_b32 %0, m0\n\ts_mov_b32 m0, %2\n\ts_nop 0\n\tglobal_load_lds_dwordx4 %1, off\n\ts_mov_b32 m0, %0":"=&s"(keep):"v"(gsrc),"s"(lds_dst):"memory");}
__device__ __forceinline__ float max3f(float a,float b,float c){float r;asm("v_max3_f32 %0, %1, %2, %3":"=v"(r):"v"(a),"v"(b),"v"(c));return r;}
__device__ __forceinline__ float max2f(float a,float b){float r;asm("v_max_f32_e32 %0, %1, %2":"=v"(r):"v"(a),"v"(b));return r;}
__device__ __forceinline__ float fadd_s(float a,float b){float r;asm("v_add_f32_e32 %0, %1, %2":"=v"(r):"v"(a),"v"(b));return r;}
__device__ __forceinline__ float fsub_s(float a,float b){float r;asm("v_sub_f32_e32 %0, %1, %2":"=v"(r):"v"(a),"v"(b));return r;}
typedef float f32x2_t __attribute__((ext_vector_type(2))); typedef __bf16 bf16x2_t __attribute__((ext_vector_type(2)));
__device__ __forceinline__ unsigned cvtpk_s(float lo,float hi){f32x2_t v={lo,hi};bf16x2_t b=__builtin_convertvector(v,bf16x2_t);return __builtin_bit_cast(unsigned,b);}
#define WAIT_BAR(N) asm volatile("s_waitcnt vmcnt(" #N ") lgkmcnt(0)\n\ts_barrier":::"memory")

__device__ __forceinline__ void qkt(f32x16&p0,f32x16&p1,const char*Kslot,const bf16x8*qr,int r32,int hi){
  const char*kb=Kslot+hi*1024+r32*16;
  #pragma unroll
  for(int d0=0;d0<4;++d0){
    const bf16x8 b0=*reinterpret_cast<const bf16x8*>(kb+d0*2048);
    const bf16x8 b1=*reinterpret_cast<const bf16x8*>(kb+d0*2048+512);
    {p0=__builtin_amdgcn_mfma_f32_32x32x16_bf16(b0,qr[d0],p0,0,0,0);p1=__builtin_amdgcn_mfma_f32_32x32x16_bf16(b1,qr[d0],p1,0,0,0);}}
}
typedef __attribute__((address_space(3))) const char* lds_cptr;
typedef short v4i16_t __attribute__((ext_vector_type(4)));
__device__ __forceinline__ void kload8(bf16x8*kf,lds_cptr kp){
  kf[0]=*(const __attribute__((address_space(3))) bf16x8*)(kp);      kf[1]=*(const __attribute__((address_space(3))) bf16x8*)(kp+512);
  kf[2]=*(const __attribute__((address_space(3))) bf16x8*)(kp+2048); kf[3]=*(const __attribute__((address_space(3))) bf16x8*)(kp+2560);
  kf[4]=*(const __attribute__((address_space(3))) bf16x8*)(kp+4096); kf[5]=*(const __attribute__((address_space(3))) bf16x8*)(kp+4608);
  kf[6]=*(const __attribute__((address_space(3))) bf16x8*)(kp+6144); kf[7]=*(const __attribute__((address_space(3))) bf16x8*)(kp+6656);
}
__device__ __forceinline__ void kload2(bf16x8*kf,lds_cptr kp,int j){ kf[2*j]=*(const __attribute__((address_space(3))) bf16x8*)(kp+j*2048); kf[2*j+1]=*(const __attribute__((address_space(3))) bf16x8*)(kp+j*2048+512); }
__device__ __forceinline__ s16x4 vtr(lds_cptr p){ return __builtin_bit_cast(s16x4,__builtin_amdgcn_ds_read_tr16_b64_v4i16((__attribute__((address_space(3))) v4i16_t*)p)); }
__device__ __forceinline__ float rowmax(const f32x16&p0,const f32x16&p1){
  float a=max3f(p0[0],p0[1],p1[0]),b=max3f(p0[2],p0[3],p1[1]);a=max3f(a,p1[2],p1[3]);
  #pragma unroll
  for(int r=4;r<16;r+=4){a=max3f(a,p0[r],p0[r+1]);b=max3f(b,p0[r+2],p0[r+3]);a=max3f(a,p1[r],p1[r+1]);b=max3f(b,p1[r+2],p1[r+3]);}
  const float m=max2f(a,b);
  auto rr=__builtin_amdgcn_permlane32_swap(__float_as_uint(m),__float_as_uint(m),false,false);
  return max2f(__uint_as_float(rr[0]),__uint_as_float(rr[1]));
}
__device__ __forceinline__ void pv(f32x16*o,int vb,bf16x8 pa0,bf16x8 pa1,bf16x8 pa2,bf16x8 pa3){
  #pragma unroll
  for(int d0=0;d0<2;++d0){s16x4 lo[4],hi[4];
    #pragma unroll
    for(int ks=0;ks<4;++ks){
      asm volatile("ds_read_b64_tr_b16 %0,%1 offset:%c2":"=&v"(lo[ks]):"v"(vb),"i"(d0*4096+ks*1024):"memory");
      asm volatile("ds_read_b64_tr_b16 %0,%1 offset:%c2":"=&v"(hi[ks]):"v"(vb),"i"(d0*4096+ks*1024+512):"memory");}
    asm volatile("s_waitcnt lgkmcnt(0)":::"memory");SBAR();
    #define PK(k) (bf16x8){lo[k][0],lo[k][1],lo[k][2],lo[k][3],hi[k][0],hi[k][1],hi[k][2],hi[k][3]}
    o[d0]=__builtin_amdgcn_mfma_f32_32x32x16_bf16(pa0,PK(0),o[d0],0,0,0);
    o[d0]=__builtin_amdgcn_mfma_f32_32x32x16_bf16(pa1,PK(1),o[d0],0,0,0);
    o[d0]=__builtin_amdgcn_mfma_f32_32x32x16_bf16(pa2,PK(2),o[d0],0,0,0);
    o[d0]=__builtin_amdgcn_mfma_f32_32x32x16_bf16(pa3,PK(3),o[d0],0,0,0);
    #undef PK
  }
}

#ifndef ATTN_STORE16
#define ATTN_STORE16(p,v) (*(u32x4*)(p)=(v))
#endif
template<int THRL> __device__ __forceinline__ void attn_unit(int b,int h,int qb,int t0,const bf16*Q,const bf16*__restrict__ K,const bf16*__restrict__ V,bf16*O,const float*__restrict__ FBrow,char*shm){
  int tid_o=threadIdx.x; asm volatile("":"+v"(tid_o)); const int tid=tid_o,lane=tid&63,r32=lane&31,hi=lane>>5; const int wid=__builtin_amdgcn_readfirstlane(tid>>6);
  const long rowbase=(long)b*SEQ; const int q0=qb*QB;
  const bf16*Qw=Q+(rowbase+q0+wid*QBLK)*DM+h*D;
  const bf16*Kh=K+(rowbase+(long)t0*KVBLK)*DM+h*D,*Vh=V+(rowbase+(long)t0*KVBLK)*DM+h*D;
  const lds_cptr shm3=(lds_cptr)shm;
  const unsigned lds0=(unsigned)(uintptr_t)shm;
  float*wsf=(float*)(shm+LDS_WS)+wid*64;
  const bf16*ksrc=Kh+(long)lane*DM+wid*8;
  const bf16*vsrc=Vh+(long)(16*(wid&3)+(lane>>2))*DM+(wid>>2)*32+(lane&3)*8;
  const unsigned kdst=lds0+LDS_K+wid*1024, vdst=lds0+LDS_V+wid*1024;
  #define DMA_K(t,slot) glds16(ksrc+(long)(t)*KVBLK*DM,(unsigned)__builtin_amdgcn_readfirstlane(kdst+(slot)))
  #define DMA_V(t,slot) glds16(vsrc+(long)(t)*KVBLK*DM,(unsigned)__builtin_amdgcn_readfirstlane(vdst+(slot)))
  const int vb0=(int)(lds0+LDS_V)+((lane>>4)&1)*32+(lane&3)*8+(4*hi+((lane&15)>>2))*64;
  const char*Kbase=shm+LDS_K; bf16x8 kf[8];
  const lds_cptr kp0=shm3+LDS_K+hi*1024+r32*16; const lds_cptr vp0=shm3+LDS_V+((lane>>4)&1)*32+(lane&3)*8+(4*hi+((lane&15)>>2))*64;
  const int NT=(q0+QB)/KVBLK-t0;
  typedef __attribute__((address_space(3))) const f32x4v* lds_f4p;
  { __attribute__((address_space(3))) f32x4v* fl=(__attribute__((address_space(3))) f32x4v*)(shm3+LDS_FB); const int n4=(q0+QB-t0*KVBLK)>>2;
    for(int i=tid;i<n4;i+=512)fl[i]=*(const f32x4v*)(FBrow+t0*KVBLK+4*i); }
  const lds_cptr flb=shm3+LDS_FB+16*hi;
  #define BIASF1(C0,t,OFF) do{ const lds_cptr fp_=flb+256*(t)+(OFF); _Pragma("unroll") for(int j_=0;j_<4;++j_){ const f32x4v a_=*(lds_f4p)(fp_+32*j_); C0[4*j_]=a_[0];C0[4*j_+1]=a_[1];C0[4*j_+2]=a_[2];C0[4*j_+3]=a_[3]; } }while(0)
  #define BIASFILL(C0,C1,t) do{ BIASF1(C0,t,0); BIASF1(C1,t,128); }while(0)
  DMA_K(0,0);DMA_V(0,0);DMA_K(1,SLOTB);
  bf16x8 qr[4];
  #pragma unroll
  for(int d0=0;d0<4;++d0)qr[d0]=*reinterpret_cast<const bf16x8*>(&Qw[(long)r32*DM+d0*16+hi*8]);
  float mhat=0.f,l_reg=0.f;f32x16 o[2];o[0]=f32x16{};o[1]=f32x16{};
  const int qrel=wid*QBLK+r32;
  #define CMASK(P0,P1,t) do{int jb_=(t)-(NT-4); if(jb_>=0)cmask(P0,P1,jb_,qrel,hi);}while(0)
  bool resc=false;
  #define START(P0,P1) do{ const float rm=rowmax(P0,P1); resc=false; \
    { const float dl=rm; mhat=fadd_s(mhat,dl); \
      _Pragma("unroll") for(int r=0;r<16;++r){P0[r]=fsub_s(P0[r],dl);P1[r]=fsub_s(P1[r],dl);} \
      } \
    _Pragma("unroll") for(int r=0;r<16;++r)P0[r]=__builtin_amdgcn_exp2f(P0[r]); }while(0)
  #define RESC() do{ if(resc){ asm volatile("s_waitcnt lgkmcnt(0)":::"memory"); \
      _Pragma("unroll") for(int d_=0;d_<2;++d_) _Pragma("unroll") for(int r=0;r<16;++r)o[d_][r]*=wsf[crow(r,hi)]; } }while(0)
  f32x16 pA0,pA1,pB0,pB1;
  int sl_prev=0,sl_cur=0,sl_next=SLOTB;
  #define ROT() do{sl_prev=sl_cur;sl_cur=sl_next;sl_next=(sl_next==(NSLOT-1)*SLOTB)?0:sl_next+SLOTB;}while(0)
  DMA_K(2,2*SLOTB);
  WAIT_BAR(3);
  BIASFILL(pA0,pA1,0); qkt(pA0,pA1,Kbase,qr,r32,hi);asm volatile("s_nop 15\n\ts_nop 7":"+v"(pA0),"+v"(pA1));CMASK(pA0,pA1,0);
  START(pA0,pA1);
  _Pragma("unroll") for(int r=0;r<16;++r)pA1[r]=__builtin_amdgcn_exp2f(pA1[r]);
  WAIT_BAR(0);
  DMA_K(3,0);DMA_V(1,SLOTB);
  ROT();
  kload8(kf,kp0+sl_cur);
  WAIT_BAR(2);
  s16x4 vlo[8],vhi[8]; u32x4 pw0,pw1,pw2,pw3;
  #define PKW(P,B) cvtpk_s(P[B],P[B+1])
  #define PAF(k) __builtin_bit_cast(bf16x8,pw##k)
  #define VFR(i) (bf16x8){vlo[i][0],vlo[i][1],vlo[i][2],vlo[i][3],vhi[i][0],vhi[i][1],vhi[i][2],vhi[i][3]}
  #define PIN(x) asm volatile("":"+v"(x))
  #define MX3(a,b,c) __builtin_fmaxf(__builtin_fmaxf((a),(b)),(c))
  #define GAPA(MF,A0,A1,A2,A3,W0,W1,PW) do{ MF; sacc+=A0; sacc+=A1; sacc+=A2; sacc+=A3; PIN(sacc); W0; W1; PIN(PW); SBAR(); }while(0)
  #define EX(v) __builtin_amdgcn_exp2f(v)
  #define GAPB(MF,X,B) do{ MF; X[B]=EX(X[B]-mhat); X[B+1]=EX(X[B+1]-mhat); X[B+2]=EX(X[B+2]-mhat); X[B+3]=EX(X[B+3]-mhat); PIN(X); SBAR(); }while(0)
  #define VRD(i) do{ vlo[i]=vtr(vp_+(((i)>>2)*4096+((i)&3)*1024)); vhi[i]=vtr(vp_+(((i)>>2)*4096+((i)&3)*1024+512)); }while(0)
  #define KRD(G,j) do{ if(G){ kload2(kf,kp0+sl_next,j); SBAR(); } }while(0)
  #define STEP(C0,C1,P0,P1,t,GK,GV,GL) do{ SBAR(); BIASF1(C0,t,0); SBAR(); \
    const lds_cptr vp_=vp0+sl_prev; \
    VRD(0); SBAR(); float sacc=(P0[0]+P0[1]); \
    GAPA(C0=__builtin_amdgcn_mfma_f32_32x32x16_bf16(kf[0],qr[0],C0,0,0,0), P0[2],P0[3],P0[4],P0[5],     pw0[0]=PKW(P0,0), pw0[1]=PKW(P0,2), pw0); \
    BIASF1(C1,t,128); VRD(4); SBAR(); GAPA(C1=__builtin_amdgcn_mfma_f32_32x32x16_bf16(kf[1],qr[0],C1,0,0,0), P0[6],P0[7],P0[8],P0[9],     pw0[2]=PKW(P0,4), pw0[3]=PKW(P0,6), pw0); \
    VRD(1); SBAR(); GAPA(C0=__builtin_amdgcn_mfma_f32_32x32x16_bf16(kf[2],qr[1],C0,0,0,0),   P0[10],P0[11],P0[12],P0[13], pw1[0]=PKW(P0,8), pw1[1]=PKW(P0,10), pw1); \
    VRD(5); SBAR(); GAPA(C1=__builtin_amdgcn_mfma_f32_32x32x16_bf16(kf[3],qr[1],C1,0,0,0),   P0[14],P0[15],P1[0],P1[1],   pw1[2]=PKW(P0,12),pw1[3]=PKW(P0,14), pw1); \
    VRD(2); SBAR(); GAPA(C0=__builtin_amdgcn_mfma_f32_32x32x16_bf16(kf[4],qr[2],C0,0,0,0),   P1[2],P1[3],P1[4],P1[5],     pw2[0]=PKW(P1,0), pw2[1]=PKW(P1,2), pw2); \
    VRD(6); SBAR(); GAPA(C1=__builtin_amdgcn_mfma_f32_32x32x16_bf16(kf[5],qr[2],C1,0,0,0),   P1[6],P1[7],P1[8],P1[9],     pw2[2]=PKW(P1,4), pw2[3]=PKW(P1,6), pw2); \
    VRD(3); SBAR(); GAPA(C0=__builtin_amdgcn_mfma_f32_32x32x16_bf16(kf[6],qr[3],C0,0,0,0),   P1[10],P1[11],P1[12],P1[13], pw3[0]=PKW(P1,8), pw3[1]=PKW(P1,10), pw3); \
    VRD(7); SBAR(); GAPA(C1=__builtin_amdgcn_mfma_f32_32x32x16_bf16(kf[7],qr[3],C1,0,0,0),   P1[14],P1[15],0.f,0.f,       pw3[2]=PKW(P1,12),pw3[3]=PKW(P1,14), pw3); \
    l_reg+=sacc; \
    if(GK){DMA_K((t)+3,sl_cur);} if(GV){DMA_V((t)+1,sl_next);} \
    CMASK(C0,C1,t); \
    { float a=MX3(C0[0],C0[1],C1[0]),b=MX3(C0[2],C0[3],C1[1]); a=MX3(a,C1[2],C1[3]); \
      _Pragma("unroll") for(int r=4;r<16;r+=4){a=MX3(a,C0[r],C0[r+1]);b=MX3(b,C0[r+2],C0[r+3]);a=MX3(a,C1[r],C1[r+1]);b=MX3(b,C1[r+2],C1[r+3]);} \
      float rm=__builtin_fmaxf(a,b); { auto rr=__builtin_amdgcn_permlane32_swap(__float_as_uint(rm),__float_as_uint(rm),false,false); rm=__builtin_fmaxf(__uint_as_float(rr[0]),__uint_as_float(rr[1])); } \
      resc=false; \
      if(__builtin_expect(__any(rm>mhat+(float)THRL),0)){ const float dl=__builtin_fmaxf(rm-mhat,0.f); mhat+=dl; \
        const float f=__builtin_amdgcn_exp2f(-dl); l_reg*=f; if(hi==0)wsf[r32]=f; resc=true; } } \
    SBAR(); \
    GAPB(o[0]=__builtin_amdgcn_mfma_f32_32x32x16_bf16(PAF(0),VFR(0),o[0],0,0,0), C0,0); \
    GAPB(o[1]=__builtin_amdgcn_mfma_f32_32x32x16_bf16(PAF(0),VFR(4),o[1],0,0,0), C0,4); \
    KRD(GL,0); GAPB(o[0]=__builtin_amdgcn_mfma_f32_32x32x16_bf16(PAF(1),VFR(1),o[0],0,0,0), C0,8); \
    KRD(GL,1); GAPB(o[1]=__builtin_amdgcn_mfma_f32_32x32x16_bf16(PAF(1),VFR(5),o[1],0,0,0), C0,12); \
    KRD(GL,2); GAPB(o[0]=__builtin_amdgcn_mfma_f32_32x32x16_bf16(PAF(2),VFR(2),o[0],0,0,0), C1,0); \
    KRD(GL,3); GAPB(o[1]=__builtin_amdgcn_mfma_f32_32x32x16_bf16(PAF(2),VFR(6),o[1],0,0,0), C1,4); \
    GAPB(o[0]=__builtin_amdgcn_mfma_f32_32x32x16_bf16(PAF(3),VFR(3),o[0],0,0,0), C1,8); \
    GAPB(o[1]=__builtin_amdgcn_mfma_f32_32x32x16_bf16(PAF(3),VFR(7),o[1],0,0,0), C1,12); \
    }while(0)
  int t=1;
  #undef CMASK
  #define CMASK(P0,P1,t) do{}while(0)
  for(;t+5<NT;t+=2){
    STEP(pB0,pB1,pA0,pA1,t,true,true,true);     WAIT_BAR(2); RESC(); ROT();
    STEP(pA0,pA1,pB0,pB1,t+1,true,true,true);   WAIT_BAR(2); RESC(); ROT();
  }
  #undef CMASK
  #define CMASK(P0,P1,t) do{int jb_=(t)-(NT-4); if(jb_>=0)cmask(P0,P1,jb_,qrel,hi);}while(0)
  #define ENDW(tt) do{ if((tt)+3<NT){WAIT_BAR(2);} else if((tt)+2<NT){WAIT_BAR(1);} else {WAIT_BAR(0);} }while(0)
  for(;t+1<NT;t+=2){
    STEP(pB0,pB1,pA0,pA1,t,(t+3<NT),(t+1<NT),(t+1<NT));       ENDW(t);   RESC(); ROT();
    STEP(pA0,pA1,pB0,pB1,t+1,(t+4<NT),(t+2<NT),(t+2<NT));     ENDW(t+1); RESC(); ROT();
  }
  STEP(pB0,pB1,pA0,pA1,NT-1,false,false,false); RESC();
  { float sacc=pB0[0]+pB0[1]; _Pragma("unroll") for(int r=2;r<16;++r)sacc+=pB0[r]; _Pragma("unroll") for(int r=0;r<16;++r)sacc+=pB1[r]; l_reg+=sacc;
    pw0=(u32x4){PKW(pB0,0),PKW(pB0,2),PKW(pB0,4),PKW(pB0,6)};pw1=(u32x4){PKW(pB0,8),PKW(pB0,10),PKW(pB0,12),PKW(pB0,14)};pw2=(u32x4){PKW(pB1,0),PKW(pB1,2),PKW(pB1,4),PKW(pB1,6)};pw3=(u32x4){PKW(pB1,8),PKW(pB1,10),PKW(pB1,12),PKW(pB1,14)};
    SBAR(); pv(o,vb0+sl_cur,PAF(0),PAF(1),PAF(2),PAF(3)); }
  #undef PKW
  #undef PAF
  #undef VFR
  #undef PIN
  #undef MX3
  #undef GAPA
  #undef GAPB
  #undef EX
  #undef VRD
  #undef KRD
  #undef STEP
  #undef ENDW
  {auto rr=__builtin_amdgcn_permlane32_swap(__float_as_uint(l_reg),__float_as_uint(l_reg),false,false);l_reg=__uint_as_float(rr[0])+__uint_as_float(rr[1]);}
  if(hi==0)wsf[32+r32]=l_reg;asm volatile("s_waitcnt lgkmcnt(0)":::"memory");
  float rli[16];
  #pragma unroll
  for(int r=0;r<16;++r)rli[r]=__builtin_amdgcn_rcpf(wsf[32+crow(r,hi)]);
  bf16*Ow=O+(rowbase+q0+wid*QBLK)*DM+h*D;
  { int r32o=r32; asm volatile("":"+v"(r32o)); bf16*stg=(bf16*)(shm+LDS_OST)+wid*2048;
    #pragma unroll
    for(int r=0;r<16;++r){const int orow=crow(r,hi);
      #pragma unroll
      for(int d0=0;d0<2;++d0)stg[orow*64+d0*32+r32o]=__float2bfloat16(o[d0][r]*rli[r]);}
    asm volatile("s_waitcnt lgkmcnt(0)":::"memory");
    #pragma unroll
    for(int i=0;i<4;++i){const int row=i*8+(lane>>3),ch=lane&7; const u32x4 v=*(const u32x4*)(stg+row*64+ch*8); ATTN_STORE16(Ow+(long)row*DM+ch*8,v);} }
  asm volatile("s_waitcnt lgkmcnt(0)\n\ts_barrier":::"memory");
  #undef DMA_K
  #undef DMA_V
  #undef CMASK
  #undef START
  #undef RESC
  #undef ROT
  #undef BIASFILL
  #undef BIASF1
}
constexpr int ATTN_LDS_BYTES=LDS_BYTES;
#undef SBAR
#undef WAIT_BAR
}
namespace cg = cooperative_groups;
#define LAS __attribute__((address_space(3)))
typedef unsigned short bf16_t;
typedef short h8 __attribute__((ext_vector_type(8)));
typedef float f4 __attribute__((ext_vector_type(4)));
typedef unsigned u4 __attribute__((ext_vector_type(4)));
typedef unsigned u2 __attribute__((ext_vector_type(2)));

#ifndef PROBE_MASK
#define PROBE_MASK 0
#endif
#ifndef MK_PER_PHASE
#define MK_PER_PHASE 0
#endif
constexpr int NTOK = 65536, SEQL = 8192, NBAT = 8, DMODEL = 1024;
constexpr int ZP = 2560, SGP = 3072, CPITCH = 1024, NINP = 5888, NIN = 5646, FFH = 2816;
constexpr int ZC_S5 = 0, ZC_MO = 256, ZC_FQ = 640, ZC_MQK = 1024, ZC_MV = 1408, ZC_FK = 1792, ZC_FV = 2176;
constexpr float EPSN = 1e-6f, LOG2E = 1.4426950408889634f, C2Q = 0.125f * 1.4426950408889634f;
constexpr int LDS_TOTAL = 147456, LDS_MISC = 147456 - 64;
constexpr int NPH_LAYER = 9, NPHASES = 2 + 2 * NPH_LAYER + 1;

constexpr size_t MiB = 1u << 20;
constexpr size_t WS_WIN = 1 * MiB, WS_W13 = 24 * MiB, WS_W2 = 46 * MiB, WS_WMG = 57 * MiB, WS_WOUT = 61 * MiB, WS_KMAT = 65 * MiB, WS_W1S = 69 * MiB, WS_W3S = 71 * MiB,
                 WS_WGLU = 73 * MiB, WS_WQK = 73 * MiB + 512 * 1024, WS_BIASP = 74 * MiB, WS_MODV = 74 * MiB + 128 * 1024, WS_LAM = 75 * MiB, WS_BBAR = 75 * MiB + 512 * 1024,
                 WS_Z = 77 * MiB, WS_SG = 397 * MiB, WS_C = 781 * MiB, WS_G32 = 909 * MiB, WS_ST = 913 * MiB, WS_ES = 950 * MiB, WS_XS = 982 * MiB,
                 WS_FB = 998 * MiB, WS_ABUF = 1000 * MiB, WS_BBUF = 1001 * MiB, WS_MS = 1002 * MiB, WS_AMX = 1002 * MiB + 64 * 1024, WS_END = 1003 * MiB,
                 WS_NRM = 1002 * MiB + 128 * 1024, WS_AQ = 1002 * MiB + 192 * 1024, WS_ROWSS4 = 1002 * MiB + 256 * 1024, WS_ROWSS = 76 * MiB, WS_BIASB_IN = 74 * MiB + 512 * 1024, WS_BIASB_F = 64 * 1024, WS_XT2 = 429 * MiB;

struct Args { const float* in[30]; float* out; unsigned char* ws; int ph_lo, ph_hi; };

__device__ __forceinline__ unsigned f2bf(float f) { unsigned u = __float_as_uint(f); return (u + 0x7fffu + ((u >> 16) & 1u)) >> 16; }
__device__ __forceinline__ unsigned pk2(float lo, float hi) { return f2bf(lo) | (f2bf(hi) << 16); }
__device__ __forceinline__ float bf2f(unsigned short h) { return __uint_as_float(((unsigned)h) << 16); }
__device__ __forceinline__ float blo(unsigned w) { return __uint_as_float(w << 16); }
__device__ __forceinline__ float bhi(unsigned w) { return __uint_as_float(w & 0xffff0000u); }
__device__ __forceinline__ float sigmf(float x) { return __builtin_amdgcn_rcpf(1.f + __expf(-x)); }
__device__ __forceinline__ float logsig(float x) { return fminf(x, 0.f) - log1pf(__expf(-fabsf(x))); }
__device__ __forceinline__ float wave_sum(float v) {
#pragma unroll
    for (int o = 1; o < 64; o <<= 1) v += __shfl_xor(v, o);
    return v;
}
#define LDS_BARRIER() asm volatile("s_waitcnt lgkmcnt(0)\n\ts_barrier" ::: "memory")
#define MFMA16(a, b, c) __builtin_amdgcn_mfma_f32_16x16x32_bf16((a), (b), (c), 0, 0, 0)

__device__ __forceinline__ int win_src(int r, float& sc) {
    sc = 1.f;
    if (r < 256) return r;
    if (r < 640) return 1024 + (r - 256);
    if (r < 1024) { sc = C2Q; return 1416 + (r - 640); }
    if (r < 1408) return 256 + (r - 1024);
    if (r < 1792) return 640 + (r - 1408);
    if (r < 2176) return 1800 + (r - 1792);
    if (r < 2560) return 2184 + (r - 2176);
    if (r < 2816) { const int j = r - 2560; if (j < 8) return 1408 + j; if (j < 14) return 2568 + (j - 8); return -1; }
    return 2574 + (r - 2816);
}
__device__ __forceinline__ void tr_tile(const float* __restrict__ W, int ldw, int ksrc0, int srccol, float scale, bf16_t* WT, int ldt, int destrow0, int kdst0, LAS float* scr, int lane) {
#pragma unroll
    for (int i = 0; i < 32; ++i) { const int kk = 2 * i + (lane >> 5); scr[kk * 33 + (lane & 31)] = (srccol >= 0) ? W[(size_t)(ksrc0 + kk) * ldw + srccol] * scale : 0.f; }
    asm volatile("s_waitcnt lgkmcnt(0)" ::: "memory");
    const int c = lane & 7;
#pragma unroll
    for (int j = 0; j < 4; ++j) { const int n = (lane >> 3) + 8 * j; const LAS float* s = scr + (8 * c) * 33 + n;
        u4 o; o.x = pk2(s[0 * 33], s[1 * 33]); o.y = pk2(s[2 * 33], s[3 * 33]); o.z = pk2(s[4 * 33], s[5 * 33]); o.w = pk2(s[6 * 33], s[7 * 33]);
        *(u4*)(WT + (size_t)(destrow0 + n) * ldt + kdst0 + 8 * c) = o; }
    asm volatile("s_waitcnt lgkmcnt(0)" ::: "memory");
}
__device__ __forceinline__ void lam_pow(float are, float aim, float dt, int d, float& lr, float& li) {
    const float mag = expf((float)d * dt * are); const float ang = (float)d * dt * aim;
    float rev = ang * 0.15915494309189535f; rev -= rintf(rev); const float th = rev * 6.283185307179586f;
    lr = mag * cosf(th); li = mag * sinf(th);
}
__device__ __forceinline__ void prologue_a(const Args& A, LAS unsigned char* lds, int tid, int lane, int wave) {
    unsigned char* ws = A.ws;
    const int G = gridDim.x, gw = blockIdx.x * 8 + wave, NGW = G * 8;
    LAS float* scr = (LAS float*)(lds + wave * 8704);
    constexpr int I_WIN = 184 * 16, I_W13 = 176 * 16, I_W2 = 32 * 44, I_WMG = 32 * 16, I_WOUT = 32 * 16, I_GLU = 8 * 4, I_L = I_WIN + I_W13 + I_W2 + I_WMG + I_WOUT + I_GLU;
    for (int it = gw; it < 2 * I_L; it += NGW) {
        const int l = it / I_L; int r = it % I_L; const int j = lane & 31;
        if (r < I_WIN) { const int grp = r % 184, kb = r / 184; float sc; const int src = win_src(grp * 32 + j, sc);
            tr_tile(A.in[6] + (size_t)l * 1024 * NIN, NIN, kb * 64, src, sc, (bf16_t*)(ws + WS_WIN) + (size_t)l * NINP * 1024, 1024, grp * 32, kb * 64, scr, lane); continue; } r -= I_WIN;
        if (r < I_W13) { const int grp = r % 176, kb = r / 176; const int dr = grp * 32, pn = dr >> 8, s = (dr >> 7) & 1, jj = dr & 127;
            tr_tile(A.in[s ? 27 : 26] + (size_t)l * 1024 * FFH, FFH, kb * 64, pn * 128 + jj + j, 1.f, (bf16_t*)(ws + WS_W13) + (size_t)l * 5632 * 1024, 1024, dr, kb * 64, scr, lane); continue; } r -= I_W13;
        if (r < I_W2) { const int grp = r % 32, kb = r / 32;
            tr_tile(A.in[28] + (size_t)l * FFH * 1024, 1024, kb * 64, grp * 32 + j, 1.f, (bf16_t*)(ws + WS_W2) + (size_t)l * 1024 * FFH, FFH, grp * 32, kb * 64, scr, lane); continue; } r -= I_W2;
        if (r < I_WMG) { const int grp = r % 32, kb = r / 32; const int k0 = kb * 64; const float* W; int ks;
            if (k0 < 256) { W = A.in[22] + (size_t)l * 256 * 1024; ks = k0; } else if (k0 < 640) { W = A.in[23] + (size_t)l * 384 * 1024; ks = k0 - 256; } else { W = A.in[24] + (size_t)l * 384 * 1024; ks = k0 - 640; }
            tr_tile(W, 1024, ks, grp * 32 + j, 1.f, (bf16_t*)(ws + WS_WMG) + (size_t)l * 1024 * 1024, 1024, grp * 32, k0, scr, lane); continue; } r -= I_WMG;
        if (r < I_WOUT) { const int grp = r % 32, kb = r / 32;
            tr_tile(A.in[25] + (size_t)l * 1024 * 1024, 1024, kb * 64, grp * 32 + j, 1.f, (bf16_t*)(ws + WS_WOUT) + (size_t)l * 1024 * 1024, 1024, grp * 32, kb * 64, scr, lane); continue; } r -= I_WOUT;
        { const int grp = r % 8, kb = r / 8;
            tr_tile(A.in[16] + (size_t)l * 256 * 256, 256, kb * 64, grp * 32 + j, 1.f, (bf16_t*)(ws + WS_WGLU) + (size_t)l * 256 * 256, 256, grp * 32, kb * 64, scr, lane); }
    }
    constexpr int E_BIAS = 2 * NINP, E_WQK = 2 * 4 * 192 * 96, E_LAM = 2 * 16 * 64 * 17, E_BB = 2 * 16 * 64 * 16, E_ALL = E_BIAS + E_WQK + E_LAM + E_BB;
    for (int e = blockIdx.x * 512 + tid; e < E_ALL; e += G * 512) {
        int r = e;
        if (r < E_BIAS) { const int l = r / NINP, d = r % NINP; float sc; const int src = win_src(d, sc); ((float*)(ws + WS_BIASP))[r] = (src >= 0) ? A.in[7][(size_t)l * NIN + src] * sc : 0.f; continue; } r -= E_BIAS;
        if (r < E_WQK) { const int d = r % 96, ep = (r / 96) % 192, lh = r / (96 * 192);
            const float v = (ep < 96) ? A.in[19][((size_t)lh * 96 + d) * 96 + ep] : A.in[20][((size_t)lh * 96 + d) * 96 + (ep - 96)] * 0.10206207261596577f;
            ((bf16_t*)(ws + WS_WQK))[r] = (bf16_t)f2bf(v); continue; } r -= E_WQK;
        if (r < E_LAM) { const int d = r % 17, lgn = r / 17, lg = lgn / 64; float lr, li; lam_pow(A.in[8][lgn], A.in[9][lgn], expf(A.in[10][lg]), d, lr, li);
            ((float*)(ws + WS_LAM))[2 * r] = lr; ((float*)(ws + WS_LAM))[2 * r + 1] = li; continue; } r -= E_LAM;
        { const int lgn = r / 16, lg = lgn / 64; const float are = A.in[8][lgn], aim = A.in[9][lgn]; float lr, li; lam_pow(are, aim, expf(A.in[10][lg]), 1, lr, li);
            const float p = lr - 1.f, q = li, den = are * are + aim * aim, cr = (p * are + q * aim) / den, ci = (q * are - p * aim) / den;
            const float br = A.in[11][r], bi = A.in[12][r];
            ((float*)(ws + WS_BBAR))[2 * r] = cr * br - ci * bi; ((float*)(ws + WS_BBAR))[2 * r + 1] = cr * bi + ci * br; }
    }
    for (int e = blockIdx.x * 512 + tid; e < 3 * 65536 / 4; e += G * 512) ((f4*)(ws + WS_ROWSS))[65536 / 4 + e] = (f4){0.f, 0.f, 0.f, 0.f};
    for (int e = blockIdx.x * 512 + tid; e < 65536 / 4; e += G * 512) ((f4*)(ws + WS_ROWSS4))[e] = (f4){0.f, 0.f, 0.f, 0.f};
    if (blockIdx.x == 0 && tid < 192) ((unsigned*)(ws + WS_NRM))[tid] = 0u;
    if (blockIdx.x == 1 && tid < 16) ((unsigned*)(ws + WS_AQ))[tid * 64] = 0u;
    __syncthreads();
    LAS float* cf = (LAS float*)lds; LAS float* part = (LAS float*)(lds + 32768);
    if ((int)blockIdx.x < 192) { for (int i = tid; i < 8192; i += 512) { const float c = A.in[1][i]; cf[i] = c * sigmf(c); } }
    __syncthreads();
    for (int it = blockIdx.x; it < 192; it += G) {
        const int l = it / 96, col = (it % 96) * 64 + lane; float acc[8];
#pragma unroll
        for (int b = 0; b < 8; ++b) acc[b] = 0.f;
        const float* wp = A.in[2] + ((size_t)l * 1024 + wave * 128) * 6144 + col;
#pragma unroll 16
        for (int k = 0; k < 128; ++k) { const float wv = wp[(size_t)k * 6144];
#pragma unroll
            for (int b = 0; b < 8; ++b) acc[b] += cf[b * 1024 + wave * 128 + k] * wv; }
#pragma unroll
        for (int b = 0; b < 8; ++b) part[(wave * 8 + b) * 64 + lane] = acc[b];
        __syncthreads();
        { const int b = tid >> 6; float s = 0.f;
#pragma unroll
          for (int w = 0; w < 8; ++w) s += part[(w * 8 + b) * 64 + lane];
          ((float*)(ws + WS_MODV))[((size_t)l * 8 + b) * 6144 + col] = s + A.in[3][(size_t)l * 6144 + col]; }
        __syncthreads();
    }
}
__device__ __forceinline__ void prologue_b(const Args& A, int tid) {
    unsigned char* ws = A.ws; const int G = gridDim.x;
    const float* LAM = (const float*)(ws + WS_LAM); const float* BB = (const float*)(ws + WS_BBAR);
    bf16_t* KM = (bf16_t*)(ws + WS_KMAT); bf16_t* W1 = (bf16_t*)(ws + WS_W1S); bf16_t* W3 = (bf16_t*)(ws + WS_W3S);
    constexpr int E_K = 2 * 16 * 16 * 256, E_W1 = 2 * 16 * 64 * 256, E_W3 = 2 * 16 * 256 * 64;
    for (int e = blockIdx.x * 512 + tid; e < E_K + E_W1 + E_W3; e += G * 512) {
        int r = e;
        if (r < E_K) { const int q = r & 15, p = (r >> 4) & 15, d = (r >> 8) & 15, lg = r >> 12; float s = 0.f;
#pragma unroll 8
            for (int n = 0; n < 64; ++n) { const size_t lgn = (size_t)lg * 64 + n; const float cr = A.in[13][(lg * 16 + p) * 64 + n], ci = A.in[14][(lg * 16 + p) * 64 + n];
                const float lr = LAM[2 * (lgn * 17 + d)], li = LAM[2 * (lgn * 17 + d) + 1], br = BB[2 * (lgn * 16 + q)], bi = BB[2 * (lgn * 16 + q) + 1];
                const float tr = lr * br - li * bi, ti = lr * bi + li * br; s += cr * tr - ci * ti; }
            const bf16_t v = (bf16_t)f2bf(s); bf16_t* km = KM + (size_t)lg * 65536;
            for (int j = d; j < 16; ++j) { km[(j * 16 + p) * 256 + (j - d) * 16 + q] = v; if (d > 0) km[((j - d) * 16 + p) * 256 + j * 16 + q] = 0; }
            continue; } r -= E_K;
        if (r < E_W1) { const int q = r & 15, j = (r >> 4) & 15, n = (r >> 8) & 63, lg = r >> 14; const size_t lgn = (size_t)lg * 64 + n;
            const float lr = LAM[2 * (lgn * 17 + 15 - j)], li = LAM[2 * (lgn * 17 + 15 - j) + 1], br = BB[2 * (lgn * 16 + q)], bi = BB[2 * (lgn * 16 + q) + 1];
            bf16_t* w = W1 + (size_t)lg * 128 * 256; w[n * 256 + j * 16 + q] = (bf16_t)f2bf(lr * br - li * bi); w[(64 + n) * 256 + j * 16 + q] = (bf16_t)f2bf(lr * bi + li * br);
            continue; } r -= E_W1;
        { const int n = r & 63, p = (r >> 6) & 15, j = (r >> 10) & 15, lg = r >> 14; const size_t lgn = (size_t)lg * 64 + n;
            const float cr = A.in[13][(lg * 16 + p) * 64 + n], ci = A.in[14][(lg * 16 + p) * 64 + n], lr = LAM[2 * (lgn * 17 + j + 1)], li = LAM[2 * (lgn * 17 + j + 1) + 1];
            bf16_t* w = W3 + (size_t)lg * 256 * 128; w[(j * 16 + p) * 128 + n] = (bf16_t)f2bf(cr * lr - ci * li); w[(j * 16 + p) * 128 + 64 + n] = (bf16_t)f2bf(-(cr * li + ci * lr)); }
    }
}
__device__ __forceinline__ void bias_gemv(const Args& A, int lane, int wave) {
    unsigned char* ws = A.ws; const int gw = blockIdx.x * 8 + wave, NGW = gridDim.x * 8;
    for (int r = gw; r < 2 * 11520; r += NGW) {
        const int l = r / 11520; int rr = r % 11520; const bf16_t* wrow; const float* sh; float* out; int stride; float add;
        if (rr < 5888) { wrow = (const bf16_t*)(ws + WS_WIN) + ((size_t)l * NINP + rr) * 1024; sh = (const float*)(ws + WS_MODV) + (size_t)l * 8 * 6144; out = (float*)(ws + WS_BIASB_IN) + (size_t)l * 8 * 5888 + rr; stride = 5888; add = ((const float*)(ws + WS_BIASP))[l * NINP + rr]; }
        else { rr -= 5888; wrow = (const bf16_t*)(ws + WS_W13) + ((size_t)l * 5632 + rr) * 1024; sh = (const float*)(ws + WS_MODV) + (size_t)l * 8 * 6144 + 3072; out = (float*)(ws + WS_BIASB_F) + (size_t)l * 8 * 5632 + rr; stride = 5632; add = 0.f; }
        const u4 w0 = *(const u4*)(wrow + 16 * lane), w1 = *(const u4*)(wrow + 16 * lane + 8);
        const float w[16] = {blo(w0.x), bhi(w0.x), blo(w0.y), bhi(w0.y), blo(w0.z), bhi(w0.z), blo(w0.w), bhi(w0.w), blo(w1.x), bhi(w1.x), blo(w1.y), bhi(w1.y), blo(w1.z), bhi(w1.z), blo(w1.w), bhi(w1.w)};
#pragma unroll
        for (int b = 0; b < 8; ++b) { const f4* sp = (const f4*)(sh + (size_t)b * 6144 + 16 * lane); float s = 0.f;
#pragma unroll
            for (int q = 0; q < 4; ++q) { const f4 v = sp[q]; s += (w[4 * q] * v.x + w[4 * q + 1] * v.y) + (w[4 * q + 2] * v.z + w[4 * q + 3] * v.w); }
            s = wave_sum(s); if (lane == 0) out[(size_t)b * stride] = s + add; }
    }
}
__device__ __forceinline__ void norm_prep0(const float* x, const float* g, const float* mod, int sc_off, bf16_t* H, float* rowss, int lane, int wave) {
    const int gw = blockIdx.x * 8 + wave, NGW = gridDim.x * 8;
    for (int row = gw; row < NTOK; row += NGW) {
        const f4* xr = (const f4*)(x + (size_t)row * 1024) + lane; f4 v[4]; float ss = 0.f;
#pragma unroll
        for (int j = 0; j < 4; ++j) { v[j] = xr[64 * j]; ss += (v[j].x * v[j].x + v[j].y * v[j].y) + (v[j].z * v[j].z + v[j].w * v[j].w); }
        ss = wave_sum(ss); if (lane == 0) rowss[row] = ss;
        const float* mp = mod + (size_t)(row >> 13) * 6144;
#pragma unroll
        for (int j = 0; j < 4; ++j) { const int col = 4 * lane + 256 * j; const f4 gg = *(const f4*)(g + col), sc = *(const f4*)(mp + sc_off + col);
            const f4 y = v[j] * gg * (sc + 1.f); u2 o; o.x = pk2(y.x, y.y); o.y = pk2(y.z, y.w); *(u2*)(H + (size_t)row * 1024 + col) = o; }
    }
}
__device__ __forceinline__ void norm_mod(const float* x, const float* g, const float* mod, int sh_off, int sc_off, bf16_t* H, int lane, int wave) {
    const int gw = blockIdx.x * 8 + wave, NGW = gridDim.x * 8;
    for (int row = gw; row < NTOK; row += NGW) {
        const f4* xr = (const f4*)(x + (size_t)row * 1024) + lane; f4 v[4]; float ss = 0.f;
#pragma unroll
        for (int j = 0; j < 4; ++j) { v[j] = xr[64 * j]; ss += (v[j].x * v[j].x + v[j].y * v[j].y) + (v[j].z * v[j].z + v[j].w * v[j].w); }
        const float rstd = rsqrtf(wave_sum(ss) * (1.f / 1024.f) + EPSN);
        const float* mp = mod + (size_t)(row >> 13) * 6144;
#pragma unroll
        for (int j = 0; j < 4; ++j) { const int col = 4 * lane + 256 * j; const f4 gg = *(const f4*)(g + col), sc = *(const f4*)(mp + sc_off + col), sh = *(const f4*)(mp + sh_off + col);
            const f4 y = v[j] * rstd * gg * (sc + 1.f) + sh; u2 o; o.x = pk2(y.x, y.y); o.y = pk2(y.z, y.w); *(u2*)(H + (size_t)row * 1024 + col) = o; }
    }
}
__device__ __forceinline__ void norm_final(float* x, const float* g, int lane, int wave) {
    const int gw = blockIdx.x * 8 + wave, NGW = gridDim.x * 8;
    for (int row = gw; row < NTOK; row += NGW) {
        f4* xr = (f4*)(x + (size_t)row * 1024) + lane; f4 v[4]; float ss = 0.f;
#pragma unroll
        for (int j = 0; j < 4; ++j) { v[j] = xr[64 * j]; ss += (v[j].x * v[j].x + v[j].y * v[j].y) + (v[j].z * v[j].z + v[j].w * v[j].w); }
        const float rstd = rsqrtf(wave_sum(ss) * (1.f / 1024.f) + EPSN);
#pragma unroll
        for (int j = 0; j < 4; ++j) { const f4 gg = *(const f4*)(g + 4 * lane + 256 * j); xr[64 * j] = v[j] * rstd * gg; }
    }
}
__device__ __forceinline__ void norm_final2(const bf16_t* XT, const float* rowss, float* out, int lane, int wave) {
    const int gw = blockIdx.x * 8 + wave, NGW = gridDim.x * 8;
    for (int row = gw; row < NTOK; row += NGW) {
        const float rstd = rsqrtf(rowss[row] * (1.f / 1024.f) + EPSN); const u2* xr = (const u2*)(XT + (size_t)row * 1024) + lane; f4* orow = (f4*)(out + (size_t)row * 1024) + lane;
        u2 w[4];
#pragma unroll
        for (int j = 0; j < 4; ++j) w[j] = xr[64 * j];
#pragma unroll
        for (int j = 0; j < 4; ++j) orow[64 * j] = (f4){blo(w[j].x) * rstd, bhi(w[j].x) * rstd, blo(w[j].y) * rstd, bhi(w[j].y) * rstd};
    }
}
__device__ __forceinline__ void scalars_phase(const Args& A, LAS unsigned char* lds, int tid, int lane, int wave) {
    unsigned char* ws = A.ws; const float* G32 = (const float*)(ws + WS_G32);
    LAS float* sm = (LAS float*)lds;
    for (int it = blockIdx.x; it < 80; it += gridDim.x) {
        if (it < 48) {
            const int b = it / 6, h = it % 6; const float* gp = G32 + ((size_t)b * SEQL + 16 * tid) * 16 + 8 + h; float v[16]; float run = 0.f;
#pragma unroll
            for (int i = 0; i < 16; ++i) { run += logsig(gp[i * 16]); v[i] = run; }
            float inc = run;
#pragma unroll
            for (int o = 1; o < 64; o <<= 1) { const float t = __shfl_up(inc, o); if (lane >= o) inc += t; }
            if (lane == 63) sm[wave] = inc;
            __syncthreads();
            float off = inc - run;
#pragma unroll
            for (int w = 0; w < 8; ++w) if (w < wave) off += sm[w];
            float* fb = (float*)(ws + WS_FB) + (size_t)it * SEQL + 16 * tid;
#pragma unroll
            for (int i = 0; i < 16; i += 4) *(f4*)(fb + i) = (f4){-(off + v[i]) * LOG2E, -(off + v[i + 1]) * LOG2E, -(off + v[i + 2]) * LOG2E, -(off + v[i + 3]) * LOG2E};
            __syncthreads();
        } else {
            const int bh = it - 48, b = bh >> 2, h = bh & 3; const float* gp = G32 + ((size_t)b * SEQL + 16 * tid) * 16; float bl[16], li[16]; float run = 0.f;
#pragma unroll
            for (int i = 0; i < 16; ++i) { li[i] = gp[i * 16 + h]; run += logsig(gp[i * 16 + 4 + h]); bl[i] = run; }
            float inc = run;
#pragma unroll
            for (int o = 1; o < 8; o <<= 1) { const float t = __shfl_up(inc, o); if ((lane & 7) >= o) inc += t; }
            const float off = inc - run; float amax = -INFINITY;
            float* ab = (float*)(ws + WS_ABUF) + (size_t)bh * SEQL + 16 * tid; float* bb = (float*)(ws + WS_BBUF) + (size_t)bh * SEQL + 16 * tid;
#pragma unroll
            for (int i = 0; i < 16; ++i) { bl[i] += off; li[i] -= bl[i]; amax = fmaxf(amax, li[i]); }
#pragma unroll
            for (int i = 0; i < 16; i += 4) { *(f4*)(ab + i) = (f4){li[i], li[i + 1], li[i + 2], li[i + 3]}; *(f4*)(bb + i) = (f4){bl[i], bl[i + 1], bl[i + 2], bl[i + 3]}; }
            amax = fmaxf(amax, __shfl_xor(amax, 1)); amax = fmaxf(amax, __shfl_xor(amax, 2)); amax = fmaxf(amax, __shfl_xor(amax, 4));
            if ((lane & 7) == 7) { sm[tid >> 3] = amax; sm[64 + (tid >> 3)] = bl[15]; }
            __syncthreads();
            if (tid == 0) { float m = 0.f; float* ms = (float*)(ws + WS_MS) + bh * 64; float* ax = (float*)(ws + WS_AMX) + bh * 64;
                for (int c = 0; c < 64; ++c) { ms[c] = m; ax[c] = sm[c]; m = sm[64 + c] + fmaxf(m, sm[c]); } }
            __syncthreads();
        }
    }
}
__device__ __forceinline__ void qk_norms(const Args& A, int l, LAS unsigned char* lds, int tid) {
    unsigned char* ws = A.ws; const bf16_t* Z = (const bf16_t*)(ws + WS_Z); unsigned* NRM = (unsigned*)(ws + WS_NRM) + l * 96;
    LAS unsigned* sm = (LAS unsigned*)lds;
    for (int it = blockIdx.x; it < 2048; it += gridDim.x) {
        if (tid < 12) sm[tid] = 0u;
        LDS_BARRIER();
        if (tid < 384) { const int t = tid / 12, j = tid % 12; const size_t tok = (size_t)it * 32 + t; const int col = (j < 6) ? ZC_FQ + j * 64 : ZC_FK + (j - 6) * 64;
            const u4* p = (const u4*)(Z + tok * ZP + col); float ss = 0.f;
#pragma unroll
            for (int q = 0; q < 8; ++q) { const u4 w = p[q]; const float a0 = blo(w.x), a1 = bhi(w.x), a2 = blo(w.y), a3 = bhi(w.y), a4 = blo(w.z), a5 = bhi(w.z), a6 = blo(w.w), a7 = bhi(w.w);
                ss += (a0 * a0 + a1 * a1) + (a2 * a2 + a3 * a3) + (a4 * a4 + a5 * a5) + (a6 * a6 + a7 * a7); }
            __hip_atomic_fetch_max(sm + j, __float_as_uint(ss), __ATOMIC_RELAXED, __HIP_MEMORY_SCOPE_WORKGROUP); }
        LDS_BARRIER();
        if (tid < 12) { const int b = (it * 32) >> 13, h = tid % 6, qk = tid / 6; __hip_atomic_fetch_max(NRM + (b * 6 + h) * 2 + qk, sm[tid], __ATOMIC_RELAXED, __HIP_MEMORY_SCOPE_AGENT); }
        LDS_BARRIER();
    }
}
__device__ __forceinline__ void s5_stage_u(const bf16_t* Z, LAS bf16_t* UL, int g, int cb, int tid) {
    u4 r[8];
#pragma unroll
    for (int q = 0; q < 8; ++q) { const int v = tid + 512 * q, c = v >> 5, j = (v >> 1) & 15, half = v & 1; const int ch = cb * 128 + c, b = ch >> 9, chunk = ch & 511;
        r[q] = *(const u4*)(Z + ((size_t)b * SEQL + chunk * 16 + j) * ZP + ZC_S5 + g * 16 + 8 * half); }
#pragma unroll
    for (int q = 0; q < 8; ++q) { const int v = tid + 512 * q, c = v >> 5, j = (v >> 1) & 15, half = v & 1; *(LAS u4*)(UL + c * 264 + j * 16 + 8 * half) = r[q]; }
}
__device__ __forceinline__ void s5_pass1(const Args& A, int l, LAS unsigned char* lds, int tid, int lane, int wave) {
    unsigned char* ws = A.ws; const bf16_t* Z = (const bf16_t*)(ws + WS_Z); float* ES = (float*)(ws + WS_ES);
    LAS bf16_t* UL = (LAS bf16_t*)lds; const int kb = lane >> 4, ln = lane & 15;
    for (int u = blockIdx.x; u < 512; u += gridDim.x) {
        const int g = u >> 5, cb = u & 31;
        s5_stage_u(Z, UL, g, cb, tid);
        const bf16_t* w1 = (const bf16_t*)(ws + WS_W1S) + ((size_t)(l * 16 + g) * 128 + 16 * wave + ln) * 256 + 8 * kb;
        h8 af[8];
#pragma unroll
        for (int ks = 0; ks < 8; ++ks) af[ks] = *(const h8*)(w1 + 32 * ks);
        LDS_BARRIER();
#pragma unroll 2
        for (int ct = 0; ct < 8; ++ct) { f4 acc = (f4){0.f, 0.f, 0.f, 0.f}; const LAS bf16_t* up = UL + (ct * 16 + ln) * 264 + (kb >> 1) * 16 + 8 * (kb & 1);
#pragma unroll
            for (int ks = 0; ks < 8; ++ks) { const h8 bf = *(const LAS h8*)(up + 32 * ks); acc = MFMA16(af[ks], bf, acc); }
            const int ch = cb * 128 + ct * 16 + ln, b = ch >> 9, chunk = ch & 511;
            *(f4*)(ES + ((size_t)(b * 16 + g) * 512 + chunk) * 128 + 16 * wave + 4 * kb) = acc; }
        LDS_BARRIER();
    }
}
__device__ __forceinline__ void s5_pass2(const Args& A, int l, LAS unsigned char* lds, int tid, int lane, int wave) {
    unsigned char* ws = A.ws; const float* ES = (const float*)(ws + WS_ES); bf16_t* XS = (bf16_t*)(ws + WS_XS); const float* LAM = (const float*)(ws + WS_LAM);
    LAS float* er_s = (LAS float*)lds; LAS float* ei_s = er_s + 512;
    for (int bg = blockIdx.x; bg < 128; bg += gridDim.x) {
        const int g = bg & 15; const size_t lgn = (size_t)(l * 16 + g) * 64 + lane;
        const float lr = LAM[2 * (lgn * 17 + 16)], li = LAM[2 * (lgn * 17 + 16) + 1]; float cr = 0.f, ci = 0.f;
        const float* e = ES + ((size_t)bg * 512 + wave * 64) * 128 + lane; bf16_t* xo = XS + ((size_t)bg * 512 + wave * 64) * 128 + lane;
        for (int c0 = 0; c0 < 64; c0 += 16) { float er[16], ei[16];
#pragma unroll
            for (int k = 0; k < 16; ++k) { er[k] = e[(size_t)(c0 + k) * 128]; ei[k] = e[(size_t)(c0 + k) * 128 + 64]; }
#pragma unroll
            for (int k = 0; k < 16; ++k) { const float nr = lr * cr - li * ci + er[k], ni = lr * ci + li * cr + ei[k]; cr = nr; ci = ni; } }
        er_s[wave * 64 + lane] = cr; ei_s[wave * 64 + lane] = ci;
        __syncthreads();
        float pr = lr, pi = li;
#pragma unroll
        for (int q = 0; q < 6; ++q) { const float t = pr * pr - pi * pi; pi = 2.f * pr * pi; pr = t; }
        cr = 0.f; ci = 0.f;
        for (int s = 0; s < wave; ++s) { const float nr = pr * cr - pi * ci + er_s[s * 64 + lane], ni = pr * ci + pi * cr + ei_s[s * 64 + lane]; cr = nr; ci = ni; }
        for (int c0 = 0; c0 < 64; c0 += 16) { float er[16], ei[16];
#pragma unroll
            for (int k = 0; k < 16; ++k) { er[k] = e[(size_t)(c0 + k) * 128]; ei[k] = e[(size_t)(c0 + k) * 128 + 64]; }
#pragma unroll
            for (int k = 0; k < 16; ++k) { xo[(size_t)(c0 + k) * 128] = (bf16_t)f2bf(cr); xo[(size_t)(c0 + k) * 128 + 64] = (bf16_t)f2bf(ci);
                const float nr = lr * cr - li * ci + er[k], ni = lr * ci + li * cr + ei[k]; cr = nr; ci = ni; } }
        __syncthreads();
    }
}
__device__ __forceinline__ void s5_pass3(const Args& A, int l, LAS unsigned char* lds, int tid, int lane, int wave) {
    unsigned char* ws = A.ws; const bf16_t* Z = (const bf16_t*)(ws + WS_Z); const bf16_t* XS = (const bf16_t*)(ws + WS_XS); bf16_t* YG = (bf16_t*)(ws + WS_C);
    LAS bf16_t* UL = (LAS bf16_t*)lds; LAS bf16_t* XL = (LAS bf16_t*)(lds + 67584); const int kb = lane >> 4, ln = lane & 15;
    for (int u = blockIdx.x; u < 512; u += gridDim.x) {
        const int g = u >> 5, cb = u & 31;
        s5_stage_u(Z, UL, g, cb, tid);
        { u4 r[4];
#pragma unroll
          for (int q = 0; q < 4; ++q) { const int v = tid + 512 * q, c = v >> 4, pc = v & 15; const int ch = cb * 128 + c, b = ch >> 9, chunk = ch & 511; r[q] = *(const u4*)(XS + ((size_t)(b * 16 + g) * 512 + chunk) * 128 + 8 * pc); }
#pragma unroll
          for (int q = 0; q < 4; ++q) { const int v = tid + 512 * q, c = v >> 4, pc = v & 15; *(LAS u4*)(XL + c * 136 + 8 * pc) = r[q]; } }
        h8 ka0[4], ka1[8], wa[2][4];
#pragma unroll
        for (int jj = 0; jj < 2; ++jj) { const int jr = jj ? 15 - wave : wave;
            const bf16_t* km = (const bf16_t*)(ws + WS_KMAT) + ((size_t)(l * 16 + g) * 256 + jr * 16 + ln) * 256 + 8 * kb;
            const bf16_t* w3 = (const bf16_t*)(ws + WS_W3S) + ((size_t)(l * 16 + g) * 256 + jr * 16 + ln) * 128 + 8 * kb;
            if (jj == 0) {
#pragma unroll
                for (int ks = 0; ks < 4; ++ks) ka0[ks] = *(const h8*)(km + 32 * ks); }
            else {
#pragma unroll
                for (int ks = 0; ks < 8; ++ks) ka1[ks] = *(const h8*)(km + 32 * ks); }
#pragma unroll
            for (int ks = 0; ks < 4; ++ks) wa[jj][ks] = *(const h8*)(w3 + 32 * ks); }
        const f4 dv = *(const f4*)(A.in[15] + (size_t)l * 256 + g * 16 + 4 * kb);
        LDS_BARRIER();
#pragma unroll 2
        for (int ct = 0; ct < 8; ++ct) {
            const int ch = cb * 128 + ct * 16 + ln, b = ch >> 9, chunk = ch & 511; const size_t tok0 = (size_t)b * SEQL + chunk * 16;
            const LAS bf16_t* ul = UL + (ct * 16 + ln) * 264; const LAS bf16_t* up = ul + (kb >> 1) * 16 + 8 * (kb & 1); const LAS bf16_t* xp = XL + (ct * 16 + ln) * 136 + 8 * kb;
            h8 ub[8], xb[4];
#pragma unroll
            for (int ks = 0; ks < 8; ++ks) ub[ks] = *(const LAS h8*)(up + 32 * ks);
#pragma unroll
            for (int ks = 0; ks < 4; ++ks) xb[ks] = *(const LAS h8*)(xp + 32 * ks);
#pragma unroll
            for (int jj = 0; jj < 2; ++jj) { const int jr = jj ? 15 - wave : wave; f4 acc = (f4){0.f, 0.f, 0.f, 0.f};
                if (jj == 0) {
#pragma unroll
                    for (int ks = 0; ks < 4; ++ks) if (2 * ks <= jr) acc = MFMA16(ka0[ks], ub[ks], acc); }
                else {
#pragma unroll
                    for (int ks = 0; ks < 8; ++ks) if (2 * ks <= jr) acc = MFMA16(ka1[ks], ub[ks], acc); }
#pragma unroll
                for (int ks = 0; ks < 4; ++ks) acc = MFMA16(wa[jj][ks], xb[ks], acc);
                const u2 uw = *(const LAS u2*)(ul + jr * 16 + 4 * kb); const f4 uu = (f4){blo(uw.x), bhi(uw.x), blo(uw.y), bhi(uw.y)};
                f4 y = acc + dv * uu;
#pragma unroll
                for (int i = 0; i < 4; ++i) { const float t = y[i]; y[i] = t * sigmf(1.5957691216057308f * (t + 0.044715f * t * t * t)); }
                u2 o; o.x = pk2(y[0], y[1]); o.y = pk2(y[2], y[3]); *(u2*)(YG + (tok0 + jr) * CPITCH + 768 + g * 16 + 4 * kb) = o; }
        }
        LDS_BARRIER();
    }
}
__device__ __forceinline__ void mlstm_qk(const Args& A, int l, LAS unsigned char* lds, int tid, int lane, int wave) {
    unsigned char* ws = A.ws; const bf16_t* Z = (const bf16_t*)(ws + WS_Z); bf16_t* QK = (bf16_t*)(ws + WS_C);
    LAS bf16_t* cx = (LAS bf16_t*)lds; const int kb = lane >> 4, ln = lane & 15; const int G = gridDim.x;
    const float* cw = A.in[17] + (size_t)l * 4 * 384; const float* cbv = A.in[18] + (size_t)l * 384;
    u4 xw[3][4];
#define MQK_LOAD(u_) do { const int tile_ = (u_) >> 2, h_ = (u_) & 3; _Pragma("unroll") for (int vi = 0; vi < 3; ++vi) { const int v = tid + 512 * vi, t = v / 12, dg = v % 12, c = h_ * 96 + 8 * dg; const int tok = tile_ * 128 + t, pos = tok & (SEQL - 1); \
        _Pragma("unroll") for (int tap = 0; tap < 4; ++tap) { xw[vi][tap] = (u4){0u, 0u, 0u, 0u}; if (pos - 3 + tap >= 0) xw[vi][tap] = *(const u4*)(Z + (size_t)(tok - 3 + tap) * ZP + ZC_MQK + c); } } } while (0)
    LAS bf16_t* WL = (LAS bf16_t*)(lds + 26624); int hcur = -1;
    int u = blockIdx.x; if (u < 2048) MQK_LOAD(u);
    for (; u < 2048; u += G) {
        const int tile = u >> 2, h = u & 3;
        if (h != hcur) { hcur = h; const bf16_t* wsrc = (const bf16_t*)(ws + WS_WQK) + (size_t)(l * 4 + h) * 192 * 96;
            for (int v = tid; v < 192 * 12; v += 512) { const int r = v / 12, dg = v % 12; *(LAS u4*)(WL + r * 104 + 8 * dg) = *(const u4*)(wsrc + r * 96 + 8 * dg); } }
#pragma unroll
        for (int vi = 0; vi < 3; ++vi) { const int v = tid + 512 * vi; const int t = v / 12, dg = v % 12, c = h * 96 + 8 * dg;
            float acc[8];
#pragma unroll
            for (int e = 0; e < 8; ++e) acc[e] = cbv[c + e];
#pragma unroll
            for (int tap = 0; tap < 4; ++tap) { const u4 x4 = xw[vi][tap]; const float* w = cw + tap * 384 + c;
                acc[0] += w[0] * blo(x4.x); acc[1] += w[1] * bhi(x4.x); acc[2] += w[2] * blo(x4.y); acc[3] += w[3] * bhi(x4.y);
                acc[4] += w[4] * blo(x4.z); acc[5] += w[5] * bhi(x4.z); acc[6] += w[6] * blo(x4.w); acc[7] += w[7] * bhi(x4.w); }
#pragma unroll
            for (int e = 0; e < 8; ++e) acc[e] = acc[e] * sigmf(acc[e]);
            u4 o; o.x = pk2(acc[0], acc[1]); o.y = pk2(acc[2], acc[3]); o.z = pk2(acc[4], acc[5]); o.w = pk2(acc[6], acc[7]);
            *(LAS u4*)(cx + t * 104 + 8 * dg) = o; }
        LDS_BARRIER();
        if (u + G < 2048) MQK_LOAD(u + G);
        h8 bfr[3];
#pragma unroll
        for (int ks = 0; ks < 3; ++ks) bfr[ks] = *(const LAS h8*)(cx + (16 * wave + ln) * 104 + 32 * ks + 8 * kb);
        const LAS bf16_t* wq = WL + ln * 104 + 8 * kb;
        const size_t tok = (size_t)tile * 128 + 16 * wave + ln;
#pragma unroll 4
        for (int et = 0; et < 12; ++et) { f4 acc = (f4){0.f, 0.f, 0.f, 0.f};
#pragma unroll
            for (int ks = 0; ks < 3; ++ks) { const h8 af = *(const LAS h8*)(wq + et * 16 * 104 + 32 * ks); acc = MFMA16(af, bfr[ks], acc); }
            const int col = (et < 6) ? (h * 96 + et * 16 + 4 * kb) : (384 + h * 96 + (et - 6) * 16 + 4 * kb);
            u2 o; o.x = pk2(acc[0], acc[1]); o.y = pk2(acc[2], acc[3]); *(u2*)(QK + tok * CPITCH + col) = o; }
        LDS_BARRIER();
    }
#undef MQK_LOAD
}
__device__ __forceinline__ void mlstm_localkv(const Args& A, LAS unsigned char* lds, int tid, int lane, int wave) {
    unsigned char* ws = A.ws; const bf16_t* Z = (const bf16_t*)(ws + WS_Z); const bf16_t* QK = (const bf16_t*)(ws + WS_C); bf16_t* ST = (bf16_t*)(ws + WS_ST);
    LAS bf16_t* KT = (LAS bf16_t*)lds; LAS bf16_t* VT = (LAS bf16_t*)(lds + 26112); const int kb = lane >> 4, ln = lane & 15; const int G = gridDim.x;
    u4 kwr[3], vwr[3]; float wl[3];
#define LKV_LOAD(u_) do { const int bh_ = (u_) >> 6, c_ = (u_) & 63, b_ = bh_ >> 2, h_ = bh_ & 3; const size_t tok0_ = (size_t)b_ * SEQL + c_ * 128; \
        const float amx_ = ((const float*)(ws + WS_AMX))[u_]; const float* ab_ = (const float*)(ws + WS_ABUF) + (size_t)bh_ * SEQL + c_ * 128; \
        _Pragma("unroll") for (int vi = 0; vi < 3; ++vi) { const int v = tid + 512 * vi, s = v / 12, dg = v % 12; wl[vi] = ab_[s] - amx_; \
            kwr[vi] = *(const u4*)(QK + (tok0_ + s) * CPITCH + 384 + h_ * 96 + 8 * dg); vwr[vi] = *(const u4*)(Z + (tok0_ + s) * ZP + ZC_MV + h_ * 96 + 8 * dg); } } while (0)
    int u = blockIdx.x; if (u < 2048) LKV_LOAD(u);
    for (; u < 2048; u += G) {
#pragma unroll
        for (int vi = 0; vi < 3; ++vi) { const int v = tid + 512 * vi; const int s = v / 12, dg = v % 12; const float w = __expf(wl[vi]); const u4 kw = kwr[vi], vw = vwr[vi];
            const int sz = s ^ ((dg & 7) << 3);
            LAS bf16_t* kt = KT + (8 * dg) * 136 + sz; LAS bf16_t* vt = VT + (8 * dg) * 136 + sz;
            kt[0] = (bf16_t)(kw.x & 0xffff); kt[136] = (bf16_t)(kw.x >> 16); kt[272] = (bf16_t)(kw.y & 0xffff); kt[408] = (bf16_t)(kw.y >> 16);
            kt[544] = (bf16_t)(kw.z & 0xffff); kt[680] = (bf16_t)(kw.z >> 16); kt[816] = (bf16_t)(kw.w & 0xffff); kt[952] = (bf16_t)(kw.w >> 16);
            vt[0] = (bf16_t)f2bf(w * blo(vw.x)); vt[136] = (bf16_t)f2bf(w * bhi(vw.x)); vt[272] = (bf16_t)f2bf(w * blo(vw.y)); vt[408] = (bf16_t)f2bf(w * bhi(vw.y));
            vt[544] = (bf16_t)f2bf(w * blo(vw.z)); vt[680] = (bf16_t)f2bf(w * bhi(vw.z)); vt[816] = (bf16_t)f2bf(w * blo(vw.w)); vt[952] = (bf16_t)f2bf(w * bhi(vw.w));
            if (dg == 0) VT[96 * 136 + (s ^ 32)] = (bf16_t)f2bf(w); }
        for (int i = tid; i < 15 * 136; i += 512) VT[97 * 136 + i] = 0;
        LDS_BARRIER();
        if (u + G < 2048) LKV_LOAD(u + G);
        if (wave < 6) {
            h8 af[4];
#pragma unroll
            for (int ks = 0; ks < 4; ++ks) af[ks] = *(const LAS h8*)(KT + (16 * wave + ln) * 136 + ((32 * ks + 8 * kb) ^ ((((16 * wave + ln) >> 3) & 7) << 3)));
#pragma unroll
            for (int ct = 0; ct < 7; ++ct) { f4 acc = (f4){0.f, 0.f, 0.f, 0.f};
#pragma unroll
                for (int ks = 0; ks < 4; ++ks) { const h8 bf = *(const LAS h8*)(VT + (16 * ct + ln) * 136 + ((32 * ks + 8 * kb) ^ ((((16 * ct + ln) >> 3) & 7) << 3))); acc = MFMA16(af[ks], bf, acc); }
                const int v = 16 * ct + ln;
                if (v < 97) { u2 o; o.x = pk2(acc[0], acc[1]); o.y = pk2(acc[2], acc[3]); *(u2*)(ST + ((size_t)u * 97 + v) * 96 + 16 * wave + 4 * kb) = o; } }
        }
        LDS_BARRIER();
    }
#undef LKV_LOAD
}
__device__ __forceinline__ void mlstm_scan(const Args& A, int tid) {
    unsigned char* ws = A.ws; bf16_t* ST = (bf16_t*)(ws + WS_ST); const float* MS = (const float*)(ws + WS_MS); const float* AMX = (const float*)(ws + WS_AMX);
    for (int idx = blockIdx.x * 512 + tid; idx < 32 * 2328; idx += gridDim.x * 512) {
        const int bh = idx / 2328, e = idx % 2328; bf16_t* p = ST + (size_t)bh * 64 * 9312 + 4 * e; float c0 = 0.f, c1 = 0.f, c2 = 0.f, c3 = 0.f;
        u2 L[8], Ln[8]; float dl[8], db[8], dln[8], dbn[8];
#define MSC_LOAD(LL, DA, DB, cb_) do { _Pragma("unroll") for (int k = 0; k < 8; ++k) { LL[k] = *(const u2*)(p + (size_t)((cb_) + k) * 9312); const float ms = MS[bh * 64 + (cb_) + k], ax = AMX[bh * 64 + (cb_) + k], mx = fmaxf(ms, ax); DA[k] = ms - mx; DB[k] = ax - mx; } } while (0)
        MSC_LOAD(L, dl, db, 0);
        for (int cb = 0; cb < 64; cb += 8) {
            if (cb + 8 < 64) MSC_LOAD(Ln, dln, dbn, cb + 8);
#pragma unroll
            for (int k = 0; k < 8; ++k) { u2 o; o.x = pk2(c0, c1); o.y = pk2(c2, c3); *(u2*)(p + (size_t)(cb + k) * 9312) = o; const float al = __expf(dl[k]), be = __expf(db[k]);
                c0 = al * c0 + be * blo(L[k].x); c1 = al * c1 + be * bhi(L[k].x); c2 = al * c2 + be * blo(L[k].y); c3 = al * c3 + be * bhi(L[k].y); }
#pragma unroll
            for (int k = 0; k < 8; ++k) { L[k] = Ln[k]; dl[k] = dln[k]; db[k] = dbn[k]; }
        }
#undef MSC_LOAD
    }
}
__device__ __forceinline__ void mlstm_out(const Args& A, int l, LAS unsigned char* lds, int tid, int lane, int wave, int ocol) {
    unsigned char* ws = A.ws; bf16_t* Z = (bf16_t*)(ws + WS_Z); const bf16_t* QK = (const bf16_t*)(ws + WS_C); const bf16_t* ST = (const bf16_t*)(ws + WS_ST);
    LAS bf16_t* Qs = (LAS bf16_t*)lds; LAS bf16_t* Ks = (LAS bf16_t*)(lds + 26624); LAS bf16_t* VT = (LAS bf16_t*)(lds + 53248); LAS bf16_t* CS = (LAS bf16_t*)(lds + 79360);
    LAS bf16_t* Ps = (LAS bf16_t*)(lds + 102656); LAS float* aL = (LAS float*)(lds + 137472); LAS float* MxL = aL + 128; LAS float* bL = aL + 256;
    const int kb = lane >> 4, ln = lane & 15; const float* ng = A.in[21] + (size_t)l * 384;
    const int G = gridDim.x; u4 qr_[3], kr_[3], vr_[3], cr_[3];
#define MO_LOAD(u_) do { const int bh_ = (u_) >> 6, c_ = (u_) & 63, b_ = bh_ >> 2, h_ = bh_ & 3; const size_t tok0_ = (size_t)b_ * SEQL + c_ * 128; \
        _Pragma("unroll") for (int vi = 0; vi < 3; ++vi) { const int v = tid + 512 * vi, s = v / 12, dg = v % 12; \
            qr_[vi] = *(const u4*)(QK + (tok0_ + s) * CPITCH + h_ * 96 + 8 * dg); kr_[vi] = *(const u4*)(QK + (tok0_ + s) * CPITCH + 384 + h_ * 96 + 8 * dg); \
            vr_[vi] = *(const u4*)(Z + (tok0_ + s) * ZP + ZC_MV + h_ * 96 + 8 * dg); \
            cr_[vi] = (u4){0u, 0u, 0u, 0u}; if (v < 97 * 12) cr_[vi] = *(const u4*)(ST + ((size_t)(u_) * 97 + s) * 96 + 8 * dg); } } while (0)
    int u = blockIdx.x; if (u < 2048) MO_LOAD(u);
    for (; u < 2048; u += G) {
        const int bh = u >> 6, c = u & 63, b = bh >> 2, h = bh & 3; const size_t tok0 = (size_t)b * SEQL + c * 128;
        const float ms = ((const float*)(ws + WS_MS))[u];
#pragma unroll
        for (int vi = 0; vi < 3; ++vi) { const int v = tid + 512 * vi; const int s = v / 12, dg = v % 12;
            *(LAS u4*)(Qs + s * 104 + 8 * dg) = qr_[vi]; *(LAS u4*)(Ks + s * 104 + 8 * dg) = kr_[vi];
            const u4 vw = vr_[vi]; LAS bf16_t* vt = VT + (8 * dg) * 136 + (s ^ ((dg & 7) << 3));
            vt[0] = (bf16_t)(vw.x & 0xffff); vt[136] = (bf16_t)(vw.x >> 16); vt[272] = (bf16_t)(vw.y & 0xffff); vt[408] = (bf16_t)(vw.y >> 16);
            vt[544] = (bf16_t)(vw.z & 0xffff); vt[680] = (bf16_t)(vw.z >> 16); vt[816] = (bf16_t)(vw.w & 0xffff); vt[952] = (bf16_t)(vw.w >> 16);
            if (v < 112 * 12) *(LAS u4*)(CS + s * 104 + 8 * dg) = cr_[vi]; }
        if (wave == 0) { const float* ab = (const float*)(ws + WS_ABUF) + (size_t)bh * SEQL + c * 128; const float* bb = (const float*)(ws + WS_BBUF) + (size_t)bh * SEQL + c * 128;
            const float a0 = ab[2 * lane], a1 = ab[2 * lane + 1]; float inc = fmaxf(a0, a1);
#pragma unroll
            for (int o = 1; o < 64; o <<= 1) { const float t = __shfl_up(inc, o); if (lane >= o) inc = fmaxf(inc, t); }
            float prev = __shfl_up(inc, 1); if (lane == 0) prev = -INFINITY;
            aL[2 * lane] = a0; aL[2 * lane + 1] = a1; MxL[2 * lane] = fmaxf(ms, fmaxf(prev, a0)); MxL[2 * lane + 1] = fmaxf(ms, inc);
            bL[2 * lane] = bb[2 * lane]; bL[2 * lane + 1] = bb[2 * lane + 1]; }
        LDS_BARRIER();
        if (u + G < 2048) MO_LOAD(u + G);
        {
            const int tt = 16 * wave + ln; const float mxt = MxL[tt], inter = __expf(ms - mxt);
            bf16_t* op = Z + (tok0 + tt) * ZP + ZC_MO + h * 96 + 4 * kb; u2 owv[6]; f4 g4v[6];
#pragma unroll
            for (int rt = 0; rt < 6; ++rt) { owv[rt] = *(const u2*)(op + 16 * rt); g4v[rt] = *(const f4*)(ng + h * 96 + 16 * rt + 4 * kb); }
            h8 qf[3];
#pragma unroll
            for (int ks = 0; ks < 3; ++ks) qf[ks] = *(const LAS h8*)(Qs + tt * 104 + 32 * ks + 8 * kb);
            f4 an[7];
#pragma unroll
            for (int rt = 0; rt < 7; ++rt) { f4 acc = (f4){0.f, 0.f, 0.f, 0.f};
#pragma unroll
                for (int ks = 0; ks < 3; ++ks) { const h8 af = *(const LAS h8*)(CS + (16 * rt + ln) * 104 + 32 * ks + 8 * kb); acc = MFMA16(af, qf[ks], acc); }
                an[rt] = acc * inter; }
            float rsum = 0.f;
            for (int st = 0; st <= wave; ++st) { f4 acc = (f4){0.f, 0.f, 0.f, 0.f};
#pragma unroll
                for (int ks = 0; ks < 3; ++ks) { const h8 af = *(const LAS h8*)(Ks + (16 * st + ln) * 104 + 32 * ks + 8 * kb); acc = MFMA16(af, qf[ks], acc); }
                const int s0 = 16 * st + 4 * kb; const f4 av = *(const LAS f4*)(aL + s0);
#pragma unroll
                for (int i = 0; i < 4; ++i) { const float w = (s0 + i <= tt) ? __expf(av[i] - mxt) : 0.f; acc[i] *= w; rsum += acc[i]; }
                u2 o; o.x = pk2(acc[0], acc[1]); o.y = pk2(acc[2], acc[3]); *(LAS u2*)(Ps + tt * 136 + s0) = o; }
            if ((wave & 1) == 0) { unsigned zz = 0u; asm volatile("" : "+v"(zz)); *(LAS u2*)(Ps + tt * 136 + 16 * (wave + 1) + 4 * kb) = (u2){zz, zz}; }
            asm volatile("s_waitcnt lgkmcnt(0)" ::: "memory");
            const int nks = (wave >> 1) + 1;
            for (int ks = 0; ks < nks; ++ks) { const h8 pf = *(const LAS h8*)(Ps + tt * 136 + 32 * ks + 8 * kb);
#pragma unroll
                for (int rt = 0; rt < 6; ++rt) { const h8 af = *(const LAS h8*)(VT + (16 * rt + ln) * 136 + ((32 * ks + 8 * kb) ^ ((((16 * rt + ln) >> 3) & 7) << 3))); an[rt] = MFMA16(af, pf, an[rt]); } }
            rsum += __shfl_xor(rsum, 16); rsum += __shfl_xor(rsum, 32);
            const float nq = __shfl(an[6][0], ln);
            const float den = rsum + nq, mt = bL[tt] + mxt, dd = __builtin_amdgcn_rcpf(fmaxf(fabsf(den), __expf(-mt)));
            float ss = 0.f;
#pragma unroll
            for (int rt = 0; rt < 6; ++rt) { an[rt] = an[rt] * dd; ss += (an[rt][0] * an[rt][0] + an[rt][1] * an[rt][1]) + (an[rt][2] * an[rt][2] + an[rt][3] * an[rt][3]); }
            ss += __shfl_xor(ss, 16); ss += __shfl_xor(ss, 32);
            const float rstd = rsqrtf(ss * (1.f / 96.f) + EPSN);
#pragma unroll
            for (int rt = 0; rt < 6; ++rt) { const u2 ow = owv[rt]; const f4 g4 = g4v[rt];
                const f4 y = an[rt] * rstd * g4; u2 o; o.x = pk2(y[0] * sigmf(blo(ow.x)), y[1] * sigmf(bhi(ow.x))); o.y = pk2(y[2] * sigmf(blo(ow.y)), y[3] * sigmf(bhi(ow.y)));
                *(u2*)(op + 16 * rt + ocol) = o; }
        }
        LDS_BARRIER();
    }
}
#define XB_TMO      128
#define XB_XCNT(j)  (256  + 64 * (j))
#define XB_XSUB(j)  (1280 + 64 * (j))
#define XB_XGEN(j)  (2304 + 64 * (j))
#define XB_TOP      3328
#define XB_TOPGEN   3392
#define XCD_BAR_WORDS 3456
#define XB_SPIN_CAP (1u << 18)

__device__ __forceinline__ unsigned xb_ld(unsigned* p)              { return __hip_atomic_load(p, __ATOMIC_RELAXED, __HIP_MEMORY_SCOPE_AGENT); }
__device__ __forceinline__ unsigned xb_add(unsigned* p, unsigned v) { return __hip_atomic_fetch_add(p, v, __ATOMIC_RELAXED, __HIP_MEMORY_SCOPE_AGENT); }
__device__ __forceinline__ unsigned xb_xcc_id() { return (unsigned)__builtin_amdgcn_s_getreg((3 << 11) | 20) & 0xFu; }
#define XB_SPIN(cond, bar) do { unsigned _sp = 0; while (cond) { __builtin_amdgcn_s_sleep(1); \
    if ((++_sp & 255u) == 0u) { if (xb_ld(&(bar)[XB_TMO])) break; if (_sp > XB_SPIN_CAP) { atomicAdd(&(bar)[XB_TMO], 1u); break; } } } } while (0)

struct XcdBarrier {
    unsigned* bar; unsigned x;
    volatile LAS unsigned* st;
};

__device__ __forceinline__ XcdBarrier xcd_barrier_post(unsigned* bar, volatile LAS unsigned* st) {
    XcdBarrier b; b.bar = bar; b.x = xb_xcc_id(); b.st = st;
    if (threadIdx.x == 0) (void)xb_add(&bar[XB_XCNT(b.x)], 1u);
    return b;
}
__device__ __forceinline__ void xcd_barrier_complete(unsigned* bar, unsigned x, unsigned& nloc, unsigned& nx) {
    const unsigned G = gridDim.x * gridDim.y * gridDim.z;
    unsigned sum, cnt, mine, sp = 0u;
    for (;;) {
        sum = 0u; cnt = 0u; mine = 0u;
#pragma unroll
        for (unsigned j = 0; j < 16; ++j) { const unsigned c = xb_ld(&bar[XB_XCNT(j)]); sum += c; cnt += (c > 0u) ? 1u : 0u; mine = (j == x) ? c : mine; }
        if (sum == G) break;
        __builtin_amdgcn_s_sleep(1);
        if ((++sp & 255u) == 0u) { if (xb_ld(&bar[XB_TMO])) break; if (sp > XB_SPIN_CAP) { atomicAdd(&bar[XB_TMO], 1u); break; } }
    }
    nloc = mine > 0u ? mine : 1u; nx = cnt > 0u ? cnt : 1u;
}

__device__ __forceinline__ void xcd_barrier(const XcdBarrier& b) {
    asm volatile("s_waitcnt vmcnt(0)" ::: "memory");
    __syncthreads();
    if (threadIdx.x == 0) {
        unsigned* bar = b.bar;
        __builtin_amdgcn_s_waitcnt(0);
        unsigned nloc = b.st[0], nx = b.st[1];
        if (nloc == 0u) { xcd_barrier_complete(bar, b.x, nloc, nx); b.st[0] = nloc; b.st[1] = nx; }
        const unsigned old = xb_add(&bar[XB_XSUB(b.x)], 1u);
        const unsigned gen = old / nloc;
        if (old + 1u == (gen + 1u) * nloc) {
            __builtin_amdgcn_fence(__ATOMIC_RELEASE, "agent");
            asm volatile("s_waitcnt vmcnt(0)" ::: "memory");
            const unsigned og = xb_add(&bar[XB_TOP], 1u);
            const unsigned tg = og / nx;
            if (og + 1u == (tg + 1u) * nx) xb_add(&bar[XB_TOPGEN], 1u);
            else XB_SPIN(xb_ld(&bar[XB_TOPGEN]) == tg, bar);
            __builtin_amdgcn_fence(__ATOMIC_ACQUIRE, "agent");
            xb_add(&bar[XB_XGEN(b.x)], 1u);
            asm volatile("s_waitcnt vmcnt(0)" ::: "memory");
        } else {
            XB_SPIN(xb_ld(&bar[XB_XGEN(b.x)]) == gen, bar);
            __builtin_amdgcn_fence(__ATOMIC_ACQUIRE, "agent");
            asm volatile("s_waitcnt vmcnt(0)" ::: "memory");
        }
    }
    __syncthreads();
}

__global__ void __launch_bounds__(512, 2) hybrid_fwd(Args args) {
    extern __shared__ __attribute__((aligned(16))) unsigned char lds_raw[];
    LAS unsigned char* lds = (LAS unsigned char*)lds_raw;
#define OPQ int tid = threadIdx.x; asm volatile("" : "+v"(tid)); const int lane = tid & 63, wave = __builtin_amdgcn_readfirstlane(tid >> 6); (void)lane; (void)wave;
    unsigned char* ws = args.ws;
    const int lo = args.ph_lo, hi = args.ph_hi;
    int ph = 0;
    if (threadIdx.x < 16) ((LAS unsigned*)(lds + LDS_MISC))[threadIdx.x] = 0u;
    __syncthreads();
    XcdBarrier xbar; xbar.bar = (unsigned*)ws; xbar.x = 0; xbar.st = nullptr;
    if (hi - lo > 1) xbar = xcd_barrier_post((unsigned*)ws, (volatile LAS unsigned*)(lds + LDS_MISC));
#define IN(k) (lo <= (k) && (k) < hi)
#ifndef PROBE_MASK
#define PROBE_MASK 0
#endif
#define REPS(i) ((((PROBE_MASK) >> (i)) & 1) ? 2 : 1)
#define SUBREP(b) for (int sr_ = 0; sr_ < ((((PROBE_MASK) >> (b)) & 1) ? 2 : 1); ++sr_)
#ifdef ONLY_SITE
#define SITE(i) ((i) == ONLY_SITE)
#else
#define SITE(i) true
#endif
#define SEAM(k) do { if (IN(k) && IN((k) + 1)) { if (hi < 0) cg::this_grid().sync(); else xcd_barrier(xbar); } } while (0)
    bf16_t* Z = (bf16_t*)(ws + WS_Z); bf16_t* SG = (bf16_t*)(ws + WS_SG); bf16_t* CB = (bf16_t*)(ws + WS_C); bf16_t* HID = (bf16_t*)(ws + WS_Z);
    if (SITE(1) && IN(0)) for (int rp_ = 0; rp_ < REPS(1); ++rp_) { OPQ prologue_a(args, lds, tid, lane, wave); } SEAM(0);
    if (SITE(2) && IN(1)) for (int rp_ = 0; rp_ < REPS(2); ++rp_) { OPQ prologue_b(args, tid); bias_gemv(args, lane, wave);
        norm_prep0(args.in[0], args.in[4], (const float*)(ws + WS_MODV), 1024, CB, (float*)(ws + WS_ROWSS), lane, wave); } SEAM(1);
    for (int l = 0; l < 2; ++l) {
        ph = 2 + l * NPH_LAYER;
        const float* mod = (const float*)(ws + WS_MODV) + (size_t)l * 8 * 6144;
        const float* xin = (l == 0) ? args.in[0] : args.out;
        if (SITE(4) && IN(ph)) for (int rp_ = 0; rp_ < REPS(4); ++rp_) { OPQ
            pg8::Gemm g{CB, (const bf16_t*)(ws + WS_WIN) + (size_t)l * NINP * 1024, NTOK, NINP, 1024, 1024, 1024}; pg8::StaticOrder S; S.init(NTOK, NINP, gridDim.x, blockIdx.x);
            pg8::EpiIn E{Z, SG, (float*)(ws + WS_G32), (const float*)(ws + WS_BIASB_IN) + (size_t)l * 8 * 5888, (const float*)(ws + WS_ROWSS) + (size_t)(2 * l) * NTOK};
            pg8::gemm_phase<pg8::EpiIn, pg8::StaticOrder, true, true>(lds, g, S, E); } SEAM(ph); ++ph;
        if (SITE(5) && IN(ph)) for (int rp_ = 0; rp_ < REPS(5); ++rp_) { OPQ SUBREP(16) scalars_phase(args, lds, tid, lane, wave); qk_norms(args, l, lds, tid); __syncthreads(); SUBREP(17) s5_pass1(args, l, lds, tid, lane, wave); __syncthreads(); SUBREP(18) mlstm_qk(args, l, lds, tid, lane, wave); } SEAM(ph); ++ph;
        if (SITE(6) && IN(ph)) for (int rp_ = 0; rp_ < REPS(6); ++rp_) { OPQ SUBREP(19) s5_pass2(args, l, lds, tid, lane, wave); SUBREP(20) mlstm_localkv(args, lds, tid, lane, wave); } SEAM(ph); ++ph;
        if (SITE(7) && IN(ph)) for (int rp_ = 0; rp_ < REPS(7); ++rp_) { OPQ mlstm_scan(args, tid); SUBREP(21) s5_pass3(args, l, lds, tid, lane, wave); } SEAM(ph); ++ph;
        if (SITE(8) && IN(ph)) for (int rp_ = 0; rp_ < REPS(8); ++rp_) { OPQ
            pg8::Gemm g{CB + 768, (const bf16_t*)(ws + WS_WGLU) + (size_t)l * 256 * 256, NTOK, 256, 256, 1024, 256}; pg8::StaticOrder S; S.init(NTOK, 256, gridDim.x, blockIdx.x);
            pg8::EpiGlu E{CB, Z};
            pg8::gemm_phase<pg8::EpiGlu, pg8::StaticOrder, false, true>(lds, g, S, E); }
        if (SITE(9) && IN(ph)) for (int rp_ = 0; rp_ < REPS(9); ++rp_) { OPQ
            const int G = gridDim.x, bx = blockIdx.x, vcu = (G % 8 == 0) ? (bx % 8) * (G / 8) + bx / 8 : bx;
            const attn_body::bf16* Zb = (const attn_body::bf16*)Z;
#ifndef NO_ATTN
            const int vb = (int)(((long)vcu * 8) / G) & 7; unsigned* qh = (unsigned*)(ws + WS_AQ) + (l * 8 + vb) * 64;
            volatile LAS unsigned* nxt = (volatile LAS unsigned*)(lds + LDS_MISC + 32);
            for (;;) {
                if (tid == 0) *nxt = __hip_atomic_fetch_add(qh, 1u, __ATOMIC_RELAXED, __HIP_MEMORY_SCOPE_AGENT);
                __syncthreads();
                const int uq = (int)*nxt;
                __syncthreads();
                if (uq >= 192) break;
                const int b = vb, qb = 31 - uq / 6, h = uq % 6, bh = b * 6 + h;
                const float* fb = (const float*)(ws + WS_FB) + (size_t)bh * SEQL;
                const unsigned* nr = (const unsigned*)(ws + WS_NRM) + l * 96 + bh * 2;
                const float thr = 2.02f * sqrtf(__uint_as_float(nr[0]) * __uint_as_float(nr[1])) + 172.f;
                const int q0 = qb * 256, NT = 4 * (qb + 1); const float lim = fb[q0] - thr;
                const int j0 = lane, j1 = lane + 64;
                const bool ok0 = (j0 < NT - 4) && (fb[64 * j0 + 63] < lim), ok1 = (j1 < NT - 4) && (fb[64 * j1 + 63] < lim);
                int t0 = (__popcll(__ballot(ok0)) + __popcll(__ballot(ok1))) & ~1; t0 = __builtin_amdgcn_readfirstlane(t0);
                attn_body::attn_unit<16>(b, h, qb, t0, Zb + ZC_FQ, Zb + ZC_FK, Zb + ZC_FV, (attn_body::bf16*)Z + ZC_FQ, fb, (char*)lds_raw); }
#endif
            __syncthreads();
#ifndef NO_MOUT
            SUBREP(23) mlstm_out(args, l, lds, tid, lane, wave, ((((PROBE_MASK) >> 23) & 1) && sr_ == 0) ? (ZC_MQK - ZC_MO) : 0);
#endif
 } SEAM(ph); ++ph;
        if (SITE(10) && IN(ph)) for (int rp_ = 0; rp_ < REPS(10); ++rp_) { OPQ
            pg8::Gemm g{Z, (const bf16_t*)(ws + WS_WMG) + (size_t)l * 1024 * 1024, NTOK, 1024, 1024, ZP, 1024}; pg8::StaticOrder S; S.init(NTOK, 1024, gridDim.x, blockIdx.x);
            pg8::EpiMerge E{SG, CB};
            pg8::gemm_phase<pg8::EpiMerge, pg8::StaticOrder, true, true>(lds, g, S, E); } SEAM(ph); ++ph;
        if (SITE(11) && IN(ph)) for (int rp_ = 0; rp_ < REPS(11); ++rp_) { OPQ
            pg8::Gemm g{CB, (const bf16_t*)(ws + WS_WOUT) + (size_t)l * 1024 * 1024, NTOK, 1024, 1024, 1024, 1024}; pg8::StaticOrder S; S.init(NTOK, 1024, gridDim.x, blockIdx.x);
            bf16_t* XB = (bf16_t*)args.out;
            if (l == 0) { pg8::EpiRes<false> E{args.in[0], XB, mod + 2048, (bf16_t*)(ws + WS_XT2), args.in[5] + l * 1024, mod + 4096, (float*)(ws + WS_ROWSS) + (size_t)(2 * l + 1) * NTOK};
                pg8::gemm_phase<pg8::EpiRes<false>, pg8::StaticOrder, true, true>(lds, g, S, E); }
            else { pg8::EpiRes<true> E{XB, XB, mod + 2048, (bf16_t*)(ws + WS_XT2), args.in[5] + l * 1024, mod + 4096, (float*)(ws + WS_ROWSS) + (size_t)(2 * l + 1) * NTOK};
                pg8::gemm_phase<pg8::EpiRes<true>, pg8::StaticOrder, true, true>(lds, g, S, E); } } SEAM(ph); ++ph;
        if (SITE(13) && IN(ph)) for (int rp_ = 0; rp_ < REPS(13); ++rp_) { OPQ
            pg8::Gemm g{(const bf16_t*)(ws + WS_XT2), (const bf16_t*)(ws + WS_W13) + (size_t)l * 5632 * 1024, NTOK, 5632, 1024, 1024, 1024}; pg8::StaticOrder S; S.init(NTOK, 5632, gridDim.x, blockIdx.x);
            pg8::EpiFfn1 E{HID, (const float*)(ws + WS_BIASB_F) + (size_t)l * 8 * 5632, (const float*)(ws + WS_ROWSS) + (size_t)(2 * l + 1) * NTOK};
            pg8::gemm_phase<pg8::EpiFfn1, pg8::StaticOrder, true, true>(lds, g, S, E); } SEAM(ph); ++ph;
        if (SITE(14) && IN(ph)) for (int rp_ = 0; rp_ < REPS(14); ++rp_) { OPQ
            pg8::Gemm g{HID, (const bf16_t*)(ws + WS_W2) + (size_t)l * 1024 * FFH, NTOK, 1024, FFH, FFH, FFH}; pg8::StaticOrder S; S.init(NTOK, 1024, gridDim.x, blockIdx.x, 1);
            bf16_t* XB = (bf16_t*)args.out;
            pg8::EpiRes<true> E{XB, (l == 0) ? XB : (bf16_t*)nullptr, mod + 5120, CB, (l == 0) ? args.in[4] + 1024 : args.in[29], (l == 0) ? mod + 8 * 6144 + 1024 : (const float*)nullptr,
                                (l == 0) ? (float*)(ws + WS_ROWSS) + (size_t)2 * NTOK : (float*)(ws + WS_ROWSS4)};
            pg8::gemm_phase<pg8::EpiRes<true>, pg8::StaticOrder, true, true>(lds, g, S, E); } SEAM(ph); ++ph;
    }
    ph = 2 + 2 * NPH_LAYER;
    if (SITE(15) && IN(ph)) for (int rp_ = 0; rp_ < REPS(15); ++rp_) { OPQ norm_final2(CB, (const float*)(ws + WS_ROWSS4), args.out, lane, wave); }
#undef IN
#undef SEAM
}

extern "C" void kernel_launch(void* const* d_in, const int* in_sizes, int n_in, void* d_out, int out_size, void* d_ws, size_t ws_size, hipStream_t stream) {
    static int grid = 0;
    if (grid == 0) {
        if (n_in != 30 || ws_size < WS_END) { fprintf(stderr, "kernel_launch: n_in %d ws %zu (need %zu)\n", n_in, ws_size, (size_t)WS_END); grid = -1; return; }
        int dev = 0, cus = 0, per_cu = 0;
        hipGetDevice(&dev); hipDeviceGetAttribute(&cus, hipDeviceAttributeMultiprocessorCount, dev);
        hipFuncSetAttribute((const void*)hybrid_fwd, hipFuncAttributeMaxDynamicSharedMemorySize, LDS_TOTAL);
        hipOccupancyMaxActiveBlocksPerMultiprocessor(&per_cu, (const void*)hybrid_fwd, 512, LDS_TOTAL);
        (void)hipGetLastError();
        if (per_cu < 1) per_cu = 1;
        grid = cus;
    }
    if (grid < 0) return;
    Args a{};
    for (int i = 0; i < 30; ++i) a.in[i] = (const float*)d_in[i];
    a.out = (float*)d_out; a.ws = (unsigned char*)d_ws;
#if MK_PER_PHASE
    for (int p = 0; p < NPHASES; ++p) { a.ph_lo = p; a.ph_hi = p + 1; hipLaunchKernelGGL(hybrid_fwd, dim3(grid), dim3(512), LDS_TOTAL, stream, a); }
#else
    a.ph_lo = 0; a.ph_hi = NPHASES;
    (void)hipMemsetAsync(d_ws, 0, 16384, stream);
    void* kargs[] = {&a};
    hipError_t e = hipLaunchCooperativeKernel((const void*)hybrid_fwd, dim3(grid), dim3(512), kargs, LDS_TOTAL, stream);
    if (e != hipSuccess) fprintf(stderr, "cooperative launch failed: %s (grid %d)\n", hipGetErrorString(e), grid);
#endif
}
```
